# Optimizing an MI355X kernel written in HIP

```python
import math
import jax, jax.numpy as jnp
from jax import lax
import numpy as np

D_MODEL = 1024
BATCH = 16
SEQ = 2048
DEPTH = 2

GRID_W = 64
LRU_WIDTH = D_MODEL
LRU_BLOCKS = 8
LRU_BW = LRU_WIDTH // LRU_BLOCKS
CONV_W = 4
CONV_PAD = (2, 1)
RG_C = 8.0
HEAD_DIM = 128
N_HEADS = D_MODEL // HEAD_DIM
N_KV_HEADS = 2
GROUP = N_HEADS // N_KV_HEADS
Q_BLOCK = 128
ROPE_THETA = 10000.0
AXIS_FREQS = HEAD_DIM // 4
D_FF = 4 * D_MODEL
EPS = 1e-6
N_RG = (DEPTH + 1) // 2
N_AT = DEPTH // 2

kernel_name = "hybrid_rglru_axial_gqa_encoder"


def rms_norm(x, g):
    xf = x.astype(jnp.float32)
    y = xf * lax.rsqrt(jnp.mean(xf * xf, axis=-1, keepdims=True) + EPS)
    return (y * g.astype(jnp.float32)).astype(x.dtype)


def rglru_direction(x, w_a, b_a, w_x, b_x, lam, reverse):
    B, L, C = x.shape
    xb = x.reshape(B, L, LRU_BLOCKS, LRU_BW)
    r = jax.nn.sigmoid((jnp.einsum('blhi,hij->blhj', xb, w_a).reshape(B, L, C) + b_a).astype(jnp.float32))
    i = jax.nn.sigmoid((jnp.einsum('blhi,hij->blhj', xb, w_x).reshape(B, L, C) + b_x).astype(jnp.float32))
    log_a = -RG_C * r * jax.nn.softplus(-lam.astype(jnp.float32))
    a = jnp.exp(log_a)
    mult = jnp.sqrt(-jnp.expm1(2.0 * log_a))
    u = mult * (i * x.astype(jnp.float32))

    def combine(p, q):
        a1, b1 = p
        a2, b2 = q
        return a1 * a2, a2 * b1 + b2

    _, h = lax.associative_scan(combine, (a, u), axis=1, reverse=reverse)
    return h.astype(x.dtype)


def rglru_block(h, w_in, conv_w, conv_b, w_a, b_a, w_x, b_x, lam, w_out):
    z = h @ w_in
    gate, rec = jnp.split(z, 2, axis=-1)
    gate = jax.nn.gelu(gate)
    rec = lax.conv_general_dilated(rec, conv_w, window_strides=(1,), padding=[CONV_PAD],
                                   dimension_numbers=('NWC', 'WIO', 'NWC'),
                                   feature_group_count=LRU_WIDTH) + conv_b
    y = (rglru_direction(rec, w_a[0], b_a[0], w_x[0], b_x[0], lam[0], False)
         + rglru_direction(rec, w_a[1], b_a[1], w_x[1], b_x[1], lam[1], True))
    return (y * gate) @ w_out


def axial_rope_tables(L):
    rows = L // GRID_W
    row = jnp.repeat(jnp.arange(rows, dtype=jnp.float32), GRID_W)
    col = jnp.tile(jnp.arange(GRID_W, dtype=jnp.float32), rows)
    inv = ROPE_THETA ** (-jnp.arange(AXIS_FREQS, dtype=jnp.float32) / AXIS_FREQS)
    ang_r = row[:, None] * inv
    ang_c = col[:, None] * inv
    return (jnp.cos(ang_r)[:, None, :], jnp.sin(ang_r)[:, None, :],
            jnp.cos(ang_c)[:, None, :], jnp.sin(ang_c)[:, None, :])


def rope_half(x, cos, sin):
    x1, x2 = jnp.split(x, 2, axis=-1)
    return jnp.concatenate([x1 * cos - x2 * sin, x2 * cos + x1 * sin], axis=-1)


def apply_axial_rope(x, tabs):
    cr, sr, cc, sc = tabs
    xf = x.astype(jnp.float32)
    xr, xc = jnp.split(xf, 2, axis=-1)
    return jnp.concatenate([rope_half(xr, cr, sr), rope_half(xc, cc, sc)], axis=-1).astype(x.dtype)


def attention_block(h, w_qkv, q_g, k_g, w_o):
    B, L, _ = h.shape
    qkv = h @ w_qkv
    q, k, v = jnp.split(qkv, [N_HEADS * HEAD_DIM, (N_HEADS + N_KV_HEADS) * HEAD_DIM], axis=-1)
    q = rms_norm(q.reshape(B, L, N_HEADS, HEAD_DIM), q_g)
    k = rms_norm(k.reshape(B, L, N_KV_HEADS, HEAD_DIM), k_g)
    v = v.reshape(B, L, N_KV_HEADS, HEAD_DIM)
    tabs = axial_rope_tables(L)
    q = apply_axial_rope(q, tabs)
    k = apply_axial_rope(k, tabs)
    nb = L // Q_BLOCK
    qb = q.reshape(B, nb, Q_BLOCK, N_KV_HEADS, GROUP, HEAD_DIM).transpose(1, 0, 2, 3, 4, 5)
    scale = 1.0 / math.sqrt(HEAD_DIM)

    def attend(qblk):
        s = jnp.einsum('bqkgd,bskd->bkgqs', qblk, k).astype(jnp.float32) * scale
        p = jax.nn.softmax(s, axis=-1).astype(v.dtype)
        return jnp.einsum('bkgqs,bskd->bqkgd', p, v)

    o = lax.map(attend, qb)
    o = o.transpose(1, 0, 2, 3, 4, 5).reshape(B, L, N_HEADS * HEAD_DIM)
    return o @ w_o


def sq_relu_mlp(h, w_up, w_down):
    u = jax.nn.relu(h @ w_up)
    return (u * u) @ w_down


def setup_inputs(seed: int = 0) -> dict:
    key = jax.random.key(seed)
    ks = jax.random.split(key, 24)
    f32 = jnp.float32
    nrm = lambda k, shape, fan_in: jax.random.normal(k, shape, f32) * (fan_in ** -0.5)
    gain = lambda k, shape: 1.0 + 0.02 * jax.random.normal(k, shape, f32)
    small = lambda k, shape: 0.01 * jax.random.normal(k, shape, f32)
    u = jax.random.uniform(ks[10], (N_RG, 2, LRU_WIDTH), f32, 0.9, 0.999)
    s = u ** (1.0 / RG_C)
    lam = jnp.log(s) - jnp.log1p(-s)
    return {
        "x": jax.random.normal(ks[0], (BATCH, SEQ, D_MODEL), f32),
        "norm_mix_g": gain(ks[1], (DEPTH, D_MODEL)),
        "norm_mlp_g": gain(ks[2], (DEPTH, D_MODEL)),
        "rg_w_in": nrm(ks[3], (N_RG, D_MODEL, 2 * LRU_WIDTH), D_MODEL),
        "rg_conv_w": nrm(ks[4], (N_RG, CONV_W, 1, LRU_WIDTH), CONV_W),
        "rg_conv_b": small(ks[5], (N_RG, LRU_WIDTH)),
        "rg_w_a": nrm(ks[6], (N_RG, 2, LRU_BLOCKS, LRU_BW, LRU_BW), LRU_BW),
        "rg_b_a": small(ks[7], (N_RG, 2, LRU_WIDTH)),
        "rg_w_x": nrm(ks[8], (N_RG, 2, LRU_BLOCKS, LRU_BW, LRU_BW), LRU_BW),
        "rg_b_x": small(ks[9], (N_RG, 2, LRU_WIDTH)),
        "rg_lam": lam,
        "rg_w_out": nrm(ks[11], (N_RG, LRU_WIDTH, D_MODEL), LRU_WIDTH),
        "at_w_qkv": nrm(ks[12], (N_AT, D_MODEL, (N_HEADS + 2 * N_KV_HEADS) * HEAD_DIM), D_MODEL),
        "at_q_g": gain(ks[13], (N_AT, HEAD_DIM)),
        "at_k_g": gain(ks[14], (N_AT, HEAD_DIM)),
        "at_w_o": nrm(ks[15], (N_AT, N_HEADS * HEAD_DIM, D_MODEL), N_HEADS * HEAD_DIM),
        "mlp_w_up": nrm(ks[16], (DEPTH, D_MODEL, D_FF), D_MODEL),
        "mlp_w_down": nrm(ks[17], (DEPTH, D_FF, D_MODEL), D_FF),
        "final_g": gain(ks[18], (D_MODEL,)),
    }


def reference(x, norm_mix_g, norm_mlp_g, rg_w_in, rg_conv_w, rg_conv_b, rg_w_a, rg_b_a,
              rg_w_x, rg_b_x, rg_lam, rg_w_out, at_w_qkv, at_q_g, at_k_g, at_w_o,
              mlp_w_up, mlp_w_down, final_g):
    for i in range(DEPTH):
        h = rms_norm(x, norm_mix_g[i])
        j = i // 2
        if i % 2 == 0:
            mix = rglru_block(h, rg_w_in[j], rg_conv_w[j], rg_conv_b[j], rg_w_a[j], rg_b_a[j],
                              rg_w_x[j], rg_b_x[j], rg_lam[j], rg_w_out[j])
        else:
            mix = attention_block(h, at_w_qkv[j], at_q_g[j], at_k_g[j], at_w_o[j])
        x = x + mix
        x = x + sq_relu_mlp(rms_norm(x, norm_mlp_g[i]), mlp_w_up[i], mlp_w_down[i])
    return rms_norm(x, final_g)
```

```cpp
#include <hip/hip_runtime.h>
#include <hip/hip_cooperative_groups.h>
#include <cstdio>
#include <cstdint>
namespace cg = cooperative_groups;

#ifndef ONE_LAUNCH
#define ONE_LAUNCH 1
#endif

#define LAS __attribute__((address_space(3)))
typedef unsigned short bf16_t;
typedef short bf16x8 __attribute__((ext_vector_type(8)));
typedef short s16x4 __attribute__((ext_vector_type(4)));
typedef float f32x4 __attribute__((ext_vector_type(4)));
typedef float f32x2 __attribute__((ext_vector_type(2)));
typedef float f32x16 __attribute__((ext_vector_type(16)));
typedef unsigned u32x4 __attribute__((ext_vector_type(4)));
typedef unsigned u32x2 __attribute__((ext_vector_type(2)));

constexpr int BATCH = 16, SEQ = 2048, DM = 1024, MTOK = BATCH * SEQ, DFF = 4096, NQKV = 1536, NKV = 256;
constexpr float EPS = 1e-6f;
constexpr int NTHREADS = 512, NWAVES = 8;
constexpr int LDS_MAIN = 131072;
constexpr int LDS_RS = LDS_MAIN + 16;
constexpr int LDS_BYTES = LDS_RS + 2048;

constexpr size_t MiB = 1024 * 1024;
constexpr size_t WS_WIN = 0, WS_WOUT = 4 * MiB, WS_WQKV = 6 * MiB, WS_WO = 9 * MiB, WS_WUP0 = 11 * MiB, WS_WUP1 = 19 * MiB,
                 WS_WDN0 = 27 * MiB, WS_WDN1 = 35 * MiB, WS_WG = 43 * MiB, WS_PART = 44 * MiB, WS_BAR = 46 * MiB, WS_HN = 48 * MiB, WS_U = 112 * MiB;
constexpr size_t WS_GATE = WS_U, WS_RECPRE = WS_U + 64 * MiB, WS_Y = WS_U + 128 * MiB, WS_HF = WS_U + 192 * MiB, WS_HB = WS_U + 256 * MiB;
constexpr size_t WS_Q = WS_U, WS_K = WS_U + 64 * MiB, WS_V = WS_U + 80 * MiB;
constexpr size_t WS_END = WS_U + 320 * MiB;

struct P {
    const float* in[19];
    float* out;
    unsigned char* ws;
    int ph_lo, ph_hi;
};
enum { I_X = 0, I_GMIX, I_GMLP, I_WIN, I_CONVW, I_CONVB, I_WA, I_BA, I_WX, I_BX, I_LAM, I_WOUT, I_WQKV, I_QG, I_KG, I_WO, I_WUP, I_WDN, I_FG };

__device__ __forceinline__ int ltid(int wv) { int t = wv * 64 + (int)__builtin_amdgcn_mbcnt_hi(~0u, __builtin_amdgcn_mbcnt_lo(~0u, 0u)); asm volatile("" : "+v"(t)); return t; }
__device__ __forceinline__ int lbid() { int b = blockIdx.x; asm volatile("" : "+s"(b)); return b; }
__device__ __forceinline__ unsigned pk2(float lo, float hi) { unsigned r; asm("v_cvt_pk_bf16_f32 %0, %1, %2" : "=v"(r) : "v"(lo), "v"(hi)); return r; }
__device__ __forceinline__ float bflo(unsigned w) { return __uint_as_float(w << 16); }
__device__ __forceinline__ float bfhi(unsigned w) { return __uint_as_float(w & 0xffff0000u); }
__device__ __forceinline__ float wave_sum(float v) {
#pragma unroll
    for (int o = 1; o < 64; o <<= 1) v += __shfl_xor(v, o);
    return v;
}
__device__ __forceinline__ float fsigmoid(float z) { return __builtin_amdgcn_rcpf(1.0f + __builtin_amdgcn_exp2f(-1.4426950408889634f * z)); }

namespace pg8 {
constexpr int BM = 256, BK = 64, HALF = 128, HTB = HALF * BK * 2, STAGE_BYTES = 8 * HTB, NXCD = 8, WGM = 8;
__host__ __device__ __forceinline__ int lds_byte(int r, int c) { const int st = (r >> 4) * 2 + (c >> 5), rr = r & 15, cc = c & 31, ob = rr * 64 + cc * 2; return st * 1024 + (ob ^ (((ob >> 9) & 1) << 5)); }
__host__ __device__ __forceinline__ void stage_rc(int b, int& R, int& C) { const int st = b / 1024, sb = b % 1024, swz = sb ^ (((sb >> 9) & 1) << 5); R = (st >> 1) * 16 + swz / 64; C = (st & 1) * 32 + (swz % 64) / 2; }
__host__ __device__ __forceinline__ int perm32(int rho) { const int n = rho >> 4, i = rho & 15; return 8 * (i >> 2) + 4 * n + (i & 3); }
struct Unit { int pm, pn; };
struct Gemm { const bf16_t* A; const bf16_t* Bt; int M, N, K; };
struct StaticOrder {
    int nM, nN, nwg, G, c;
    __device__ void init(int M, int N, int G_, int c_) { nM = M / BM; nN = N / BM; nwg = nM * nN; G = G_; c = c_; }
    __device__ bool next(int i, Unit& u) const {
        const long L = (long)i * G + c; if (L >= nwg) return false;
        int wgid = (int)L; { const int q = nwg / NXCD, r = nwg % NXCD, xcd = wgid % NXCD, off = wgid / NXCD; wgid = (xcd < r ? xcd * (q + 1) : r * (q + 1) + (xcd - r) * q) + off; }
        const int nig = WGM * nN, gid = wgid / nig, fm = gid * WGM, gsz = (nM - fm) < WGM ? (nM - fm) : WGM;
        u.pm = fm + ((wgid % nig) % gsz); u.pn = (wgid % nig) / gsz; return true;
    }
};

__device__ __forceinline__ void row_scales_load(const float* part, int row0, int fq, f32x4 (&t)[2][4]);
__device__ __forceinline__ void row_scales_reduce(const f32x4 (&t)[2][4], float (&rs)[2][4]);
template <class Epi>
__device__ __forceinline__ void gemm_phase(LAS unsigned char* lds, const Gemm g, const StaticOrder& S, const Epi& E, int wv) {
    const int tid = ltid(wv), wid = __builtin_amdgcn_readfirstlane(tid >> 6), lane = tid & 63, wr = wid >> 2, wc = wid & 3, fr = lane & 15, fq = lane >> 4;
    const int K = g.K, nt = K / BK;
    unsigned voffA[2], voffB[2];
#pragma unroll
    for (int i = 0; i < 2; ++i) { int R, C; stage_rc(tid * 16 + i * 8192, R, C); const int Rb = Epi::PERM ? ((R & ~31) + perm32(R & 31)) : R;
        voffA[i] = (unsigned)(R * K + C) * 2u; voffB[i] = (unsigned)(Rb * K + C) * 2u; }
    const size_t kstep = (size_t)(BK * 2);
    const size_t hstep = (size_t)HALF * K * 2;
    const size_t tstep = 2 * hstep;
    const unsigned ldsw = (unsigned)wid * 1024u;
    const int aoff = lds_byte(wr * 64 + fr, fq * 8), boff = lds_byte(wc * 32 + fr, fq * 8);
#define PG8_SA(b, h) (((b) * 2 + (h)) * HTB)
#define PG8_SB(b, h) ((4 + (b) * 2 + (h)) * HTB)
#define PG8_STAGE(bufoff, gbase, voff) do { _Pragma("unroll") for (int _i = 0; _i < 2; ++_i) \
        __builtin_amdgcn_global_load_lds((const unsigned*)((const char*)(gbase) + (voff)[_i]), (LAS unsigned*)(lds + (bufoff) + ldsw + _i * 8192), 16, 0, 0); } while (0)
#define PG8_LDA(dst, b, h) do { _Pragma("unroll") for (int m = 0; m < 4; ++m) _Pragma("unroll") for (int k = 0; k < 2; ++k) dst[m][k] = *(const LAS bf16x8*)(lds + PG8_SA(b, h) + aoff + m * 2048 + k * 1024); } while (0)
#define PG8_LDB(dst, b, h) do { _Pragma("unroll") for (int n = 0; n < 2; ++n) _Pragma("unroll") for (int k = 0; k < 2; ++k) dst[n][k] = *(const LAS bf16x8*)(lds + PG8_SB(b, h) + boff + n * 2048 + k * 1024); } while (0)
#define PG8_MMA(ai, bj, At, Bt) do { __builtin_amdgcn_s_setprio(1); _Pragma("unroll") for (int m = 0; m < 4; ++m) _Pragma("unroll") for (int n = 0; n < 2; ++n) _Pragma("unroll") for (int k = 0; k < 2; ++k) \
        acc[ai][bj][m][n] = __builtin_amdgcn_mfma_f32_16x16x32_bf16(Bt[n][k], At[m][k], acc[ai][bj][m][n], 0, 0, 0); __builtin_amdgcn_s_setprio(0); } while (0)
#define PG8_WAIT_V(n) asm volatile("s_waitcnt vmcnt(" #n ")" ::: "memory")
#define PG8_WAIT_L(n) asm volatile("s_waitcnt lgkmcnt(" #n ")" ::: "memory")
#define PG8_BAR __builtin_amdgcn_s_barrier()
#define PG8_SCHED __builtin_amdgcn_sched_barrier(0)
    Unit cur, nxt; int ui = 0;
    if (!S.next(0, cur)) return;
    f32x4 acc[2][2][4][2];
#pragma unroll
    for (int a = 0; a < 2; ++a)
#pragma unroll
        for (int b = 0; b < 2; ++b)
#pragma unroll
            for (int m = 0; m < 4; ++m)
#pragma unroll
                for (int n = 0; n < 2; ++n) acc[a][b][m][n] = (f32x4){0.f, 0.f, 0.f, 0.f};
    bf16x8 At[4][2], B0[2][2], B1[2][2];
    const char* cA = (const char*)g.A + (size_t)cur.pm * tstep; const char* cB = (const char*)g.Bt + (size_t)cur.pn * tstep;
    LAS float* rsl = (LAS float*)(lds + LDS_RS);
#define PG8_RS_LOAD(pm_, ta, tb) do { const float* _pp = E.part + ((size_t)(pm_) * BM + wid * 32 + (lane >> 1)) * 16 + (lane & 1) * 8; ta = *(const f32x4*)_pp; tb = *(const f32x4*)(_pp + 4); } while (0)
#define PG8_RS_PUBLISH(ta, tb, par) do { float _ss = ((ta[0] + ta[1]) + (ta[2] + ta[3])) + ((tb[0] + tb[1]) + (tb[2] + tb[3])); _ss += __shfl_xor(_ss, 1); \
        if (!(lane & 1)) rsl[(par) * 256 + wid * 32 + (lane >> 1)] = rsqrtf(_ss * (1.f / DM) + EPS); } while (0)
    f32x4 ta0, tb0; if constexpr (Epi::ROWSCALE) PG8_RS_LOAD(cur.pm, ta0, tb0);
    PG8_STAGE(PG8_SB(0, 0), cB, voffB); PG8_STAGE(PG8_SA(0, 0), cA, voffA); PG8_STAGE(PG8_SB(0, 1), cB + hstep, voffB); PG8_STAGE(PG8_SA(0, 1), cA + hstep, voffA);
    if (wr == 1) PG8_BAR;
    PG8_WAIT_V(4); PG8_BAR;
    PG8_STAGE(PG8_SB(1, 0), cB + kstep, voffB); PG8_STAGE(PG8_SA(1, 0), cA + kstep, voffA); PG8_STAGE(PG8_SB(1, 1), cB + hstep + kstep, voffB);
    PG8_WAIT_V(6); PG8_BAR;
    if constexpr (Epi::ROWSCALE) PG8_RS_PUBLISH(ta0, tb0, 0);
    for (;;) {
        const bool has_next = S.next(ui + 1, nxt);
        const char* nA = has_next ? (const char*)g.A + (size_t)nxt.pm * tstep : cA; const char* nB = has_next ? (const char*)g.Bt + (size_t)nxt.pn * tstep : cB;
        for (int t = 0; t < nt; t += 2) {
            const bool last = (t == nt - 2);
            const char* a1 = cA + (size_t)(t + 1) * kstep;
            const char* a2 = last ? nA : cA + (size_t)(t + 2) * kstep; const char* b2 = last ? nB : cB + (size_t)(t + 2) * kstep;
            const char* a3 = a2 + kstep; const char* b3 = b2 + kstep;
            PG8_LDB(B0, 0, 0); PG8_SCHED; PG8_LDA(At, 0, 0); PG8_STAGE(PG8_SA(1, 1), a1 + hstep, voffA);
            PG8_WAIT_L(8); PG8_BAR; PG8_WAIT_L(0); PG8_MMA(0, 0, At, B0); PG8_BAR; PG8_SCHED;
            PG8_LDB(B1, 0, 1); PG8_STAGE(PG8_SB(0, 0), b2, voffB);
            PG8_BAR; PG8_WAIT_L(0); PG8_MMA(0, 1, At, B1); PG8_BAR;
            PG8_LDA(At, 0, 1); PG8_STAGE(PG8_SA(0, 0), a2, voffA);
            PG8_BAR; PG8_WAIT_L(0); PG8_MMA(1, 0, At, B0); PG8_BAR; PG8_SCHED;
            PG8_STAGE(PG8_SB(0, 1), b2 + hstep, voffB);
            PG8_WAIT_V(6); PG8_BAR; PG8_MMA(1, 1, At, B1); PG8_BAR;
            PG8_LDB(B0, 1, 0); PG8_SCHED; PG8_LDA(At, 1, 0); PG8_STAGE(PG8_SA(0, 1), a2 + hstep, voffA);
            PG8_WAIT_L(8); PG8_BAR; PG8_WAIT_L(0); PG8_MMA(0, 0, At, B0); PG8_BAR; PG8_SCHED;
            PG8_LDB(B1, 1, 1); PG8_STAGE(PG8_SB(1, 0), b3, voffB);
            PG8_BAR; PG8_WAIT_L(0); PG8_MMA(0, 1, At, B1); PG8_BAR;
            PG8_LDA(At, 1, 1); PG8_STAGE(PG8_SA(1, 0), a3, voffA);
            PG8_BAR; PG8_WAIT_L(0); PG8_MMA(1, 0, At, B0); PG8_BAR; PG8_SCHED;
            PG8_STAGE(PG8_SB(1, 1), b3 + hstep, voffB);
            PG8_WAIT_V(6); PG8_BAR; PG8_MMA(1, 1, At, B1); PG8_BAR;
        }
        if constexpr (Epi::ROWSCALE) { f32x4 ta, tb; if (has_next) PG8_RS_LOAD(nxt.pm, ta, tb);
            E(acc, cur, wr, wc, fr, fq, rsl + (ui & 1) * 256); if (has_next) PG8_RS_PUBLISH(ta, tb, (ui + 1) & 1); }
        else E(acc, cur, wr, wc, fr, fq, rsl);
        if (!has_next) break;
#pragma unroll
        for (int a = 0; a < 2; ++a)
#pragma unroll
            for (int b = 0; b < 2; ++b)
#pragma unroll
                for (int m = 0; m < 4; ++m)
#pragma unroll
                    for (int n = 0; n < 2; ++n) acc[a][b][m][n] = (f32x4){0.f, 0.f, 0.f, 0.f};
        cur = nxt; cA = nA; cB = nB; ++ui;
    }
    PG8_WAIT_V(0);
    if (wr == 0) PG8_BAR;
    PG8_BAR;
#undef PG8_RS_PUBLISH
#undef PG8_RS_LOAD
#undef PG8_SA
#undef PG8_SB
#undef PG8_STAGE
#undef PG8_LDA
#undef PG8_LDB
#undef PG8_MMA
#undef PG8_WAIT_V
#undef PG8_WAIT_L
#undef PG8_BAR
#undef PG8_SCHED
}

__device__ __forceinline__ float gelu_tanh(float x) {
    const float y = 1.5957691216057308f * (x + 0.044715f * x * x * x);
    return x * fsigmoid(y);
}
template <int MODE> __device__ __forceinline__ void store8(bf16_t* p, f32x4 v0, f32x4 v1, float rs) {
    f32x2 a = {v0[0], v0[1]}, b = {v0[2], v0[3]}, c = {v1[0], v1[1]}, d = {v1[2], v1[3]};
    a = a * rs; b = b * rs; c = c * rs; d = d * rs;
    if (MODE == 1) {
        a.x = gelu_tanh(a.x); a.y = gelu_tanh(a.y); b.x = gelu_tanh(b.x); b.y = gelu_tanh(b.y); c.x = gelu_tanh(c.x); c.y = gelu_tanh(c.y); d.x = gelu_tanh(d.x); d.y = gelu_tanh(d.y);
    }
    if (MODE == 2) {
        const f32x2 z = {0.f, 0.f};
        a = __builtin_elementwise_max(a, z); b = __builtin_elementwise_max(b, z); c = __builtin_elementwise_max(c, z); d = __builtin_elementwise_max(d, z);
        a = a * a; b = b * b; c = c * c; d = d * d;
    }
    u32x4 w; w.x = pk2(a.x, a.y); w.y = pk2(b.x, b.y); w.z = pk2(c.x, c.y); w.w = pk2(d.x, d.y);
    *(u32x4*)p = w;
}
__device__ __forceinline__ float row_rs(const float* part, int row) {
    const f32x4* pp = (const f32x4*)(part + (size_t)row * 16); const f32x4 a = pp[0], b = pp[1], c = pp[2], d = pp[3];
    const float ss = ((a[0] + a[1]) + (a[2] + a[3])) + ((b[0] + b[1]) + (b[2] + b[3])) + ((c[0] + c[1]) + (c[2] + c[3])) + ((d[0] + d[1]) + (d[2] + d[3]));
    return rsqrtf(ss * (1.f / DM) + EPS);
}
__device__ __forceinline__ void row_scales_load(const float* part, int row0, int fq, f32x4 (&t)[2][4]) {
#pragma unroll
    for (int ai = 0; ai < 2; ++ai)
#pragma unroll
        for (int m = 0; m < 4; ++m) t[ai][m] = *(const f32x4*)(part + (size_t)(row0 + ai * HALF + m * 16) * 16 + fq * 4);
}
__device__ __forceinline__ void row_scales_reduce(const f32x4 (&t)[2][4], float (&rs)[2][4]) {
#pragma unroll
    for (int ai = 0; ai < 2; ++ai)
#pragma unroll
        for (int m = 0; m < 4; ++m) { float ss = (t[ai][m][0] + t[ai][m][1]) + (t[ai][m][2] + t[ai][m][3]); ss += __shfl_xor(ss, 16); ss += __shfl_xor(ss, 32); rs[ai][m] = rsqrtf(ss * (1.f / DM) + EPS); }
}
struct EpiWin {
    static constexpr bool PERM = true, ROWSCALE = true;
    bf16_t* gate; bf16_t* rec; const float* part;
    __device__ __forceinline__ void operator()(const f32x4 (&acc)[2][2][4][2], const Unit& u, int wr, int wc, int fr, int fq, const LAS float* rsl) const {
        const int row0 = u.pm * BM + wr * 64 + fr; const bool isg = u.pn < 4; bf16_t* base = isg ? gate : rec;
        const int col0 = (u.pn & 3) * BM + wc * 32 + 8 * fq;
#pragma unroll
        for (int ai = 0; ai < 2; ++ai)
#pragma unroll
            for (int m = 0; m < 4; ++m) { bf16_t* rowp = base + (size_t)(row0 + ai * HALF + m * 16) * DM + col0; const float rs = rsl[ai * HALF + wr * 64 + m * 16 + fr];
#pragma unroll
                for (int bj = 0; bj < 2; ++bj) { if (isg) store8<1>(rowp + bj * HALF, acc[ai][bj][m][0], acc[ai][bj][m][1], rs); else store8<0>(rowp + bj * HALF, acc[ai][bj][m][0], acc[ai][bj][m][1], rs); } }
    }
};
struct EpiRelu2 {
    static constexpr bool PERM = true, ROWSCALE = true;
    bf16_t* U; const float* part;
    __device__ __forceinline__ void operator()(const f32x4 (&acc)[2][2][4][2], const Unit& u, int wr, int wc, int fr, int fq, const LAS float* rsl) const {
        const int row0 = u.pm * BM + wr * 64 + fr; const int col0 = u.pn * BM + wc * 32 + 8 * fq;
#pragma unroll
        for (int ai = 0; ai < 2; ++ai)
#pragma unroll
            for (int m = 0; m < 4; ++m) { const int row = row0 + ai * HALF + m * 16; bf16_t* rowp = U + (size_t)row * DFF + col0;
                const float rs = rsl[ai * HALF + wr * 64 + m * 16 + fr];
#pragma unroll
                for (int bj = 0; bj < 2; ++bj) store8<2>(rowp + bj * HALF, acc[ai][bj][m][0], acc[ai][bj][m][1], rs); }
    }
};
struct EpiQKV {
    static constexpr bool PERM = true, ROWSCALE = true;
    unsigned char* ws; const float* part;
    __device__ __forceinline__ void operator()(const f32x4 (&acc)[2][2][4][2], const Unit& u, int wr, int wc, int fr, int fq, const LAS float* rsl) const {
        const int row0 = u.pm * BM + wr * 64 + fr;
        const bool isq = u.pn < 4; bf16_t* base = (bf16_t*)(ws + WS_Q + (isq ? (size_t)0 : (size_t)(64 + 16 * (u.pn - 4)) * MiB)); const int ldc = isq ? DM : NKV; const int colt = isq ? u.pn * BM : 0;
        const int col0 = colt + wc * 32 + 8 * fq;
#pragma unroll
        for (int ai = 0; ai < 2; ++ai)
#pragma unroll
            for (int m = 0; m < 4; ++m) { const int row = row0 + ai * HALF + m * 16; bf16_t* rowp = base + (size_t)row * ldc + col0;
                const float rs = rsl[ai * HALF + wr * 64 + m * 16 + fr];
#pragma unroll
                for (int bj = 0; bj < 2; ++bj) store8<0>(rowp + bj * HALF, acc[ai][bj][m][0], acc[ai][bj][m][1], rs); }
    }
};
struct EpiResid {
    static constexpr bool PERM = true, ROWSCALE = false;
    bf16_t* xb; float* part; int stats;
    __device__ __forceinline__ void operator()(const f32x4 (&acc)[2][2][4][2], const Unit& u, int wr, int wc, int fr, int fq, const LAS float* rsl) const {
        const int row0 = u.pm * BM + wr * 64 + fr, col0 = u.pn * BM + wc * 32 + 8 * fq;
        u32x4 bsa[2][4][2];
#pragma unroll
        for (int ai = 0; ai < 2; ++ai)
#pragma unroll
            for (int m = 0; m < 4; ++m)
#pragma unroll
                for (int bj = 0; bj < 2; ++bj) bsa[ai][m][bj] = *(const u32x4*)(xb + (size_t)(row0 + ai * HALF + m * 16) * DM + col0 + bj * HALF);
        asm volatile("" ::: "memory");
#pragma unroll
        for (int ai = 0; ai < 2; ++ai)
#pragma unroll
            for (int m = 0; m < 4; ++m) { const int row = row0 + ai * HALF + m * 16; bf16_t* rowp = xb + (size_t)row * DM + col0;
                float ss = 0.f;
#pragma unroll
                for (int bj = 0; bj < 2; ++bj) { const u32x4 b = bsa[ai][m][bj]; const f32x4 a0 = acc[ai][bj][m][0], a1 = acc[ai][bj][m][1];
                    const float v0 = bflo(b.x) + a0[0], v1 = bfhi(b.x) + a0[1], v2 = bflo(b.y) + a0[2], v3 = bfhi(b.y) + a0[3];
                    const float v4 = bflo(b.z) + a1[0], v5 = bfhi(b.z) + a1[1], v6 = bflo(b.w) + a1[2], v7 = bfhi(b.w) + a1[3];
                    ss += ((v0 * v0 + v1 * v1) + (v2 * v2 + v3 * v3)) + ((v4 * v4 + v5 * v5) + (v6 * v6 + v7 * v7));
                    u32x4 w; w.x = pk2(v0, v1); w.y = pk2(v2, v3); w.z = pk2(v4, v5); w.w = pk2(v6, v7);
                    *(u32x4*)(rowp + bj * HALF) = w; }
                if (stats) { ss += __shfl_xor(ss, 16); ss += __shfl_xor(ss, 32); if (fq == 0) part[(size_t)row * 16 + u.pn * 4 + wc] = ss; } }
    }
};
}

__device__ __forceinline__ void transpose_item(const float* W, int K, int N, bf16_t* WT, int row_off, LAS float* scr, int item, int lane, const float* gk = nullptr) {
    const int nblk = N / 32, kb = item / nblk, nb = item % nblk, k0 = 64 * kb, n0 = 32 * nb;
    float tv[32];
#pragma unroll
    for (int i = 0; i < 32; ++i) tv[i] = W[(size_t)(k0 + 2 * i + (lane >> 5)) * N + n0 + (lane & 31)];
#pragma unroll
    for (int i = 0; i < 32; ++i) scr[(2 * i + (lane >> 5)) * 33 + (lane & 31)] = tv[i];
    asm volatile("s_waitcnt lgkmcnt(0)" ::: "memory");
    const int c = lane & 7;
#pragma unroll
    for (int j = 0; j < 4; ++j) { const int n = (lane >> 3) + 8 * j; const LAS float* s = scr + (8 * c) * 33 + n;
        f32x4 g0 = (f32x4){1.f, 1.f, 1.f, 1.f}, g1 = g0; if (gk) { g0 = *(const f32x4*)(gk + k0 + 8 * c); g1 = *(const f32x4*)(gk + k0 + 8 * c + 4); }
        u32x4 o; o.x = pk2(s[0 * 33] * g0[0], s[1 * 33] * g0[1]); o.y = pk2(s[2 * 33] * g0[2], s[3 * 33] * g0[3]); o.z = pk2(s[4 * 33] * g1[0], s[5 * 33] * g1[1]); o.w = pk2(s[6 * 33] * g1[2], s[7 * 33] * g1[3]);
        *(u32x4*)(WT + (size_t)(row_off + n0 + n) * K + k0 + 8 * c) = o; }
    asm volatile("s_waitcnt lgkmcnt(0)" ::: "memory");
}
__device__ __forceinline__ void norm_rows_bf16(const float* src, const float* g, bf16_t* dst, int gw, int ngw, int lane) {
    f32x4 gv[4];
#pragma unroll
    for (int j = 0; j < 4; ++j) gv[j] = *((const f32x4*)g + lane + 64 * j);
    for (int m = gw; m < MTOK; m += ngw) {
        const f32x4* xr = (const f32x4*)(src + (size_t)m * DM) + lane;
        f32x4 v[4]; float s = 0.f;
#pragma unroll
        for (int j = 0; j < 4; ++j) { v[j] = xr[64 * j]; s += (v[j].x * v[j].x + v[j].y * v[j].y) + (v[j].z * v[j].z + v[j].w * v[j].w); }
        const float rs = rsqrtf(wave_sum(s) * (1.f / DM) + EPS);
        u32x2* o8 = (u32x2*)(dst + (size_t)m * DM) + lane;
#pragma unroll
        for (int j = 0; j < 4; ++j) { u32x2 w; w.x = pk2(v[j].x * rs * gv[j].x, v[j].y * rs * gv[j].y); w.y = pk2(v[j].z * rs * gv[j].z, v[j].w * rs * gv[j].w); o8[64 * j] = w; }
    }
}
__device__ __forceinline__ void xb_rows(const float* src, bf16_t* dst, float* part, int gw, int ngw, int lane) {
    for (int m = 4 * gw; m < MTOK; m += 4 * ngw) {
        f32x4 v[4][4];
#pragma unroll
        for (int u = 0; u < 4; ++u)
#pragma unroll
            for (int j = 0; j < 4; ++j) v[u][j] = *((const f32x4*)(src + (size_t)(m + u) * DM) + lane + 64 * j);
#pragma unroll
        for (int u = 0; u < 4; ++u) {
            float s = 0.f;
#pragma unroll
            for (int j = 0; j < 4; ++j) s += (v[u][j].x * v[u][j].x + v[u][j].y * v[u][j].y) + (v[u][j].z * v[u][j].z + v[u][j].w * v[u][j].w);
            s = wave_sum(s);
            u32x2* o8 = (u32x2*)(dst + (size_t)(m + u) * DM) + lane;
#pragma unroll
            for (int j = 0; j < 4; ++j) { u32x2 w; w.x = pk2(v[u][j].x, v[u][j].y); w.y = pk2(v[u][j].z, v[u][j].w); o8[64 * j] = w; }
            if (lane < 16) part[(size_t)(m + u) * 16 + lane] = lane == 0 ? s : 0.f;
        }
    }
}
__device__ __forceinline__ void final_norm_rows(const bf16_t* src, const float* g, float* dst, int gw, int ngw, int lane) {
    f32x4 gv[4];
#pragma unroll
    for (int j = 0; j < 4; ++j) gv[j] = *((const f32x4*)g + lane + 64 * j);
    for (int m = 4 * gw; m < MTOK; m += 4 * ngw) {
        u32x2 w[4][4];
#pragma unroll
        for (int u = 0; u < 4; ++u)
#pragma unroll
            for (int j = 0; j < 4; ++j) w[u][j] = *((const u32x2*)(src + (size_t)(m + u) * DM) + lane + 64 * j);
#pragma unroll
        for (int u = 0; u < 4; ++u) {
            f32x4 v[4]; float s = 0.f;
#pragma unroll
            for (int j = 0; j < 4; ++j) { v[j] = (f32x4){bflo(w[u][j].x), bfhi(w[u][j].x), bflo(w[u][j].y), bfhi(w[u][j].y)}; s += (v[j].x * v[j].x + v[j].y * v[j].y) + (v[j].z * v[j].z + v[j].w * v[j].w); }
            const float rs = rsqrtf(wave_sum(s) * (1.f / DM) + EPS);
            f32x4* o = (f32x4*)(dst + (size_t)(m + u) * DM) + lane;
#pragma unroll
            for (int j = 0; j < 4; ++j) o[64 * j] = v[j] * rs * gv[j];
        }
    }
}
__device__ __forceinline__ void norm_rows_f32_inplace(float* buf, const float* g, int gw, int ngw, int lane) {
    f32x4 gv[4];
#pragma unroll
    for (int j = 0; j < 4; ++j) gv[j] = *((const f32x4*)g + lane + 64 * j);
    for (int m = gw; m < MTOK; m += ngw) {
        f32x4* xr = (f32x4*)(buf + (size_t)m * DM) + lane;
        f32x4 v[4]; float s = 0.f;
#pragma unroll
        for (int j = 0; j < 4; ++j) { v[j] = xr[64 * j]; s += (v[j].x * v[j].x + v[j].y * v[j].y) + (v[j].z * v[j].z + v[j].w * v[j].w); }
        const float rs = rsqrtf(wave_sum(s) * (1.f / DM) + EPS);
#pragma unroll
        for (int j = 0; j < 4; ++j) xr[64 * j] = v[j] * rs * gv[j];
    }
}

__device__ __forceinline__ void prep_phase(const P& p, LAS unsigned char* lds, int wave, int lane) {
    LAS float* scr = (LAS float*)(lds + wave * 16384);
    const int gw = lbid() * NWAVES + wave, ngw = gridDim.x * NWAVES;
    unsigned char* ws = p.ws;
    constexpr int IT_WIN = 16 * 64, IT_WOUT = 16 * 32, IT_WQKV = 16 * 48, IT_WO = 16 * 32, IT_UP = 16 * 128, IT_DN = 64 * 32, IT_G = 32 * 8;
    constexpr int NIT = IT_WIN + IT_G;
    (void)IT_WOUT; (void)IT_WQKV; (void)IT_WO; (void)IT_UP; (void)IT_DN;
    for (int it = gw; it < NIT; it += ngw) {
        int r = it;
        if (r < IT_WIN) { transpose_item(p.in[I_WIN], DM, 2 * DM, (bf16_t*)(ws + WS_WIN), 0, scr, r, lane, p.in[I_GMIX]); continue; } r -= IT_WIN;
        {
            const int mi = r >> 3, sub = r & 7, ax = mi >> 4, d = (mi >> 3) & 1, h = mi & 7;
            const float* W = (ax ? p.in[I_WX] : p.in[I_WA]) + (size_t)(d * 8 + h) * 128 * 128;
            transpose_item(W, 128, 128, (bf16_t*)(ws + WS_WG) + (size_t)h * 512 * 128, (d * 2 + ax) * 128, scr, sub, lane);
        }
    }
    xb_rows(p.in[I_X], (bf16_t*)(ws + WS_HN), (float*)(ws + WS_PART), gw, ngw, lane);
}

constexpr int TL = 64, NCHK = SEQ / TL;
constexpr int A_PITCH = 272, H_PITCH = 132;
constexpr int L_A = 0, L_H = 17408, L_CW = L_H + 33792, L_RAW = L_CW + 2560;
static_assert(L_RAW + 68 * 256 <= LDS_MAIN, "lds");

template <bool REV>
__device__ __forceinline__ void lru_scan(f32x4 (&av)[4], f32x4 (&uv)[4], float& S, int fr, int fq) {
    const int fqe = REV ? 3 - fq : fq;
    const bool g1 = fqe >= 1, g2 = fqe >= 2, g3 = fqe >= 3;
    float Ak[4][4], Hk[4][4];
#pragma unroll
    for (int mi = 0; mi < 4; ++mi) {
        const int m = REV ? 3 - mi : mi;
        const f32x4 a = av[m], u = uv[m];
        float Hl, Al;
        if (!REV) { Hl = u[0]; Al = a[0]; Hl = a[1] * Hl + u[1]; Al *= a[1]; Hl = a[2] * Hl + u[2]; Al *= a[2]; Hl = a[3] * Hl + u[3]; Al *= a[3]; }
        else      { Hl = u[3]; Al = a[3]; Hl = a[2] * Hl + u[2]; Al *= a[2]; Hl = a[1] * Hl + u[1]; Al *= a[1]; Hl = a[0] * Hl + u[0]; Al *= a[0]; }
#pragma unroll
        for (int k = 0; k < 4; ++k) { const int src = fr + 16 * (REV ? 3 - k : k); Ak[mi][k] = __shfl(Al, src); Hk[mi][k] = __shfl(Hl, src); }
    }
#pragma unroll
    for (int mi = 0; mi < 4; ++mi) {
        const int m = REV ? 3 - mi : mi;
        const f32x4 a = av[m]; f32x4 u = uv[m];
        const float S0 = S, S1 = Ak[mi][0] * S0 + Hk[mi][0], S2 = Ak[mi][1] * S1 + Hk[mi][1], S3 = Ak[mi][2] * S2 + Hk[mi][2];
        S = Ak[mi][3] * S3 + Hk[mi][3];
        float prev = S0; prev = g1 ? S1 : prev; prev = g2 ? S2 : prev; prev = g3 ? S3 : prev;
        if (!REV) {
#pragma unroll
            for (int j = 0; j < 4; ++j) { prev = a[j] * prev + u[j]; u[j] = prev; }
        } else {
#pragma unroll
            for (int j = 3; j >= 0; --j) { prev = a[j] * prev + u[j]; u[j] = prev; }
        }
        uv[m] = u;
    }
}

#define XB_TMO      128
#define XB_XCNT(j)  (256  + 64 * (j))
#define XB_XSUB(j)  (1280 + 64 * (j))
#define XB_XGEN(j)  (2304 + 64 * (j))
#define XB_TOP      3328
#define XB_TOPGEN   3392
#define XCD_BAR_WORDS 3456
#define XB_SPIN_CAP (1u << 20)
__device__ __forceinline__ unsigned xb_ld(unsigned* p)              { return __hip_atomic_load(p, __ATOMIC_RELAXED, __HIP_MEMORY_SCOPE_AGENT); }
__device__ __forceinline__ unsigned xb_add(unsigned* p, unsigned v) { return __hip_atomic_fetch_add(p, v, __ATOMIC_RELAXED, __HIP_MEMORY_SCOPE_AGENT); }
__device__ __forceinline__ unsigned xb_xcc_id() { return (unsigned)__builtin_amdgcn_s_getreg((3 << 11) | 20) & 0xFu; }
#define XB_SPIN(cond, bar) do { unsigned _sp = 0; while (cond) { __builtin_amdgcn_s_sleep(1); \
    if ((++_sp & 255u) == 0u) { if (xb_ld(&(bar)[XB_TMO])) break; if (_sp > XB_SPIN_CAP) { atomicAdd(&(bar)[XB_TMO], 1u); break; } } } } while (0)
struct XcdBarrier { unsigned* bar; unsigned x; volatile LAS unsigned* st; };
__device__ __forceinline__ XcdBarrier xcd_barrier_post(unsigned* bar, volatile LAS unsigned* st) {
    XcdBarrier b; b.bar = bar; b.x = xb_xcc_id(); b.st = st;
    if (threadIdx.x == 0) (void)xb_add(&bar[XB_XCNT(b.x)], 1u);
    return b;
}
__device__ __forceinline__ void xcd_barrier_complete(unsigned* bar, unsigned x, unsigned& nloc, unsigned& nx) {
    const unsigned G = gridDim.x * gridDim.y * gridDim.z;
    unsigned sum, cnt, mine, sp = 0u;
    for (;;) {
        sum = 0u; cnt = 0u; mine = 0u;
#pragma nounroll
        for (unsigned j = 0; j < 16; ++j) { const unsigned c = xb_ld(&bar[XB_XCNT(j)]); sum += c; cnt += (c > 0u) ? 1u : 0u; mine = (j == x) ? c : mine; }
        if (sum == G) break;
        __builtin_amdgcn_s_sleep(1);
        if ((++sp & 255u) == 0u) { if (xb_ld(&bar[XB_TMO])) break; if (sp > XB_SPIN_CAP) { atomicAdd(&bar[XB_TMO], 1u); break; } }
    }
    nloc = mine > 0u ? mine : 1u; nx = cnt > 0u ? cnt : 1u;
}
__device__ __forceinline__ void xcd_barrier(const XcdBarrier& b, int wv) {
    asm volatile("s_waitcnt vmcnt(0)" ::: "memory");
    __syncthreads();
    unsigned* bar = b.bar; const unsigned bx = b.x;
    if (wv == 0 && __builtin_amdgcn_mbcnt_hi(~0u, __builtin_amdgcn_mbcnt_lo(~0u, 0u)) == 0u) {
        __builtin_amdgcn_s_waitcnt(0);
        unsigned nloc = b.st[0], nx = b.st[1];
        if (nloc == 0u) { xcd_barrier_complete(bar, bx, nloc, nx); b.st[0] = nloc; b.st[1] = nx; }
        const unsigned old = xb_add(&bar[XB_XSUB(bx)], 1u);
        const unsigned gen = old / nloc;
        if (old + 1u == (gen + 1u) * nloc) {
            __builtin_amdgcn_fence(__ATOMIC_RELEASE, "agent");
            asm volatile("s_waitcnt vmcnt(0)" ::: "memory");
            const unsigned og = xb_add(&bar[XB_TOP], 1u);
            const unsigned tg = og / nx;
            if (og + 1u == (tg + 1u) * nx) xb_add(&bar[XB_TOPGEN], 1u);
            else XB_SPIN(xb_ld(&bar[XB_TOPGEN]) == tg, bar);
            __builtin_amdgcn_fence(__ATOMIC_ACQUIRE, "agent");
            xb_add(&bar[XB_XGEN(bx)], 1u);
            asm volatile("s_waitcnt vmcnt(0)" ::: "memory");
        } else {
            XB_SPIN(xb_ld(&bar[XB_XGEN(bx)]) == gen, bar);
            __builtin_amdgcn_fence(__ATOMIC_ACQUIRE, "agent");
            asm volatile("s_waitcnt vmcnt(0)" ::: "memory");
        }
    }
    __syncthreads();
}

constexpr int WC_OUT = 0, WC_QKV = WC_OUT + (DM / 16) * (DM / 32), WC_O = WC_QKV + (DM / 16) * (NQKV / 32), WC_UP0 = WC_O + (DM / 16) * (DM / 32), WC_UP1 = WC_UP0 + (DM / 16) * (DFF / 32),
              WC_DN0 = WC_UP1 + (DM / 16) * (DFF / 32), WC_DN1 = WC_DN0 + (DFF / 16) * (DM / 32), WC_END = WC_DN1 + (DFF / 16) * (DM / 32);
struct WcItem { const float* src; bf16_t* dst; const float* gk; int N; };
template <int K, int N> __device__ __forceinline__ WcItem wconv_mk(const float* W, bf16_t* WT, const float* gk, int r, int lane) {
    constexpr int nblk = N / 32; const int k0 = (r / nblk) * 16 + (lane >> 5) * 8, n = (r % nblk) * 32 + (lane & 31);
    return WcItem{W + (size_t)k0 * N + n, WT + (size_t)n * K + k0, gk ? gk + k0 : nullptr, N};
}
__device__ __forceinline__ WcItem wconv_decode(const P& p, int idx, int lane) {
    unsigned char* ws = p.ws;
    if (idx < WC_QKV) return wconv_mk<DM, DM>(p.in[I_WOUT], (bf16_t*)(ws + WS_WOUT), nullptr, idx - WC_OUT, lane);
    if (idx < WC_O)   return wconv_mk<DM, NQKV>(p.in[I_WQKV], (bf16_t*)(ws + WS_WQKV), p.in[I_GMIX] + DM, idx - WC_QKV, lane);
    if (idx < WC_UP0) return wconv_mk<DM, DM>(p.in[I_WO], (bf16_t*)(ws + WS_WO), nullptr, idx - WC_O, lane);
    if (idx < WC_UP1) return wconv_mk<DM, DFF>(p.in[I_WUP], (bf16_t*)(ws + WS_WUP0), p.in[I_GMLP], idx - WC_UP0, lane);
    if (idx < WC_DN0) return wconv_mk<DM, DFF>(p.in[I_WUP] + (size_t)DM * DFF, (bf16_t*)(ws + WS_WUP1), p.in[I_GMLP] + DM, idx - WC_UP1, lane);
    if (idx < WC_DN1) return wconv_mk<DFF, DM>(p.in[I_WDN], (bf16_t*)(ws + WS_WDN0), nullptr, idx - WC_DN0, lane);
    return wconv_mk<DFF, DM>(p.in[I_WDN] + (size_t)DM * DFF, (bf16_t*)(ws + WS_WDN1), nullptr, idx - WC_DN1, lane);
}
__device__ __forceinline__ void wconv_load(const WcItem& t, float (&v)[8]) {
#pragma unroll
    for (int e = 0; e < 8; ++e) v[e] = t.src[(size_t)e * t.N];
}
__device__ __forceinline__ void wconv_store(const WcItem& t, const float (&v)[8]) {
    f32x4 g0 = (f32x4){1.f, 1.f, 1.f, 1.f}, g1 = g0; if (t.gk) { g0 = *(const f32x4*)(t.gk); g1 = *(const f32x4*)(t.gk + 4); }
    u32x4 o; o.x = pk2(v[0] * g0[0], v[1] * g0[1]); o.y = pk2(v[2] * g0[2], v[3] * g0[3]); o.z = pk2(v[4] * g1[0], v[5] * g1[1]); o.w = pk2(v[6] * g1[2], v[7] * g1[3]);
    *(u32x4*)t.dst = o;
}
__device__ __forceinline__ void lru_mid_barrier(unsigned char* ws, LAS unsigned char* lds, int wv) {
    unsigned char* w = ws; asm volatile("" : "+s"(w));
    XcdBarrier xb; xb.bar = (unsigned*)(w + WS_BAR); xb.x = xb_xcc_id(); xb.st = (volatile LAS unsigned*)(lds + LDS_MAIN);
    xcd_barrier(xb, wv);
}
__device__ __forceinline__ void lru_phase(const P& p, LAS unsigned char* lds, int wv) {
    const int tid = ltid(wv), wid = __builtin_amdgcn_readfirstlane(tid >> 6), lane = tid & 63, fr = lane & 15, fq = lane >> 4;
    const bf16_t* RECPRE = (const bf16_t*)(p.ws + WS_RECPRE);
    const bf16_t* WG = (const bf16_t*)(p.ws + WS_WG);
    const int cv = tid & 15, tp = tid >> 4, lt0 = 2 * tp;
    LAS float* cw = (LAS float*)(lds + L_CW);
    LAS float* hbuf = (LAS float*)(lds + L_H);
    const bf16_t* GATE = (const bf16_t*)(p.ws + WS_GATE);
    bf16_t* Y = (bf16_t*)(p.ws + WS_Y);
    const int G = gridDim.x, ngi = (256 + G - 1) / G;
    const int ngw = G * NWAVES; int widx = lbid() * NWAVES + wid;
    for (int gi = 0; gi < ngi; ++gi) {
        const int grp = lbid() + gi * G;
        if (grp >= 256) { lru_mid_barrier(p.ws, lds, wv); continue; }
        const int d = grp & 1, h = (grp >> 1) & 7, b = grp >> 4;
        bf16_t* HD = (bf16_t*)(p.ws + (d ? WS_HB : WS_HF));
        const bf16_t* HP = (const bf16_t*)(p.ws + (d ? WS_HF : WS_HB));
        bf16x8 bfr[2][4];
#pragma unroll
        for (int nn = 0; nn < 2; ++nn)
#pragma unroll
            for (int kk = 0; kk < 4; ++kk) { const int row = (d * 2 + nn) * 128 + wid * 16 + fr;
                bfr[nn][kk] = *(const bf16x8*)(WG + ((size_t)h * 512 + row) * 128 + kk * 32 + fq * 8); }
        const int chl = wid * 16 + fr, chg = d * DM + h * 128 + chl;
        const float nba = -1.4426950408889634f * p.in[I_BA][chg], nbx = -1.4426950408889634f * p.in[I_BX][chg], clu = -8.0f * log1pf(expf(-p.in[I_LAM][chg]));
        __syncthreads();
        for (int i = tid; i < 640; i += NTHREADS) { const int tap = i >> 7, ch = i & 127; cw[i] = tap < 4 ? p.in[I_CONVW][tap * DM + h * 128 + ch] : p.in[I_CONVB][h * 128 + ch]; }
#define LRU_DMA_ROWS(c) do { _Pragma("unroll") for (int qi = 0; qi < 3; ++qi) { const int qq = wid + 8 * qi; if (qq < 17) { \
            int t = (c) * TL + 4 * qq + (lane >> 4) - 2; t = t < 0 ? 0 : (t > SEQ - 1 ? SEQ - 1 : t); \
            __builtin_amdgcn_global_load_lds((const unsigned*)(RECPRE + ((size_t)(b * SEQ + t)) * DM + h * 128 + (lane & 15) * 8), (LAS unsigned*)(lds + L_RAW + qq * 1024), 16, 0, 0); } } } while (0)
        LRU_DMA_ROWS(d ? NCHK - 1 : 0);
        asm volatile("s_waitcnt vmcnt(0)" ::: "memory");
        __syncthreads();
        float S = 0.f;
        for (int ci = 0; ci < NCHK; ++ci) {
            const int c = d ? NCHK - 1 - ci : ci;
            if (ci == NCHK / 2) lru_mid_barrier(p.ws, lds, wv);
            const bool comb = ci >= NCHK / 2;
            float wcv[8]; const bool wc_on = widx < WC_END; WcItem wt{};
            if (wc_on) { wt = wconv_decode(p, widx, lane); wconv_load(wt, wcv); }
            u32x4 ph[2], gt[2];
            if (comb) {
#pragma unroll
                for (int tt = 0; tt < 2; ++tt) { const size_t o = ((size_t)(b * SEQ + c * TL + lt0 + tt)) * DM + h * 128 + cv * 8; ph[tt] = *(const u32x4*)(HP + o); gt[tt] = *(const u32x4*)(GATE + o); }
            }
            {
                u32x4 rw[5];
#pragma unroll
                for (int i = 0; i < 5; ++i) { const int t = c * TL + lt0 - 2 + i; const u32x4 v = *(const LAS u32x4*)(lds + L_RAW + (lt0 + i) * 256 + cv * 16);
                    rw[i] = (t >= 0 && t < SEQ) ? v : (u32x4){0u, 0u, 0u, 0u}; }
                f32x4 wv[5][2];
#pragma unroll
                for (int tap = 0; tap < 5; ++tap) { wv[tap][0] = *(const LAS f32x4*)(cw + tap * 128 + cv * 8); wv[tap][1] = *(const LAS f32x4*)(cw + tap * 128 + cv * 8 + 4); }
                u32x4 o0, o1;
#pragma unroll
                for (int e = 0; e < 4; ++e) {
                    f32x2 W[5], X[5];
#pragma unroll
                    for (int tap = 0; tap < 5; ++tap) W[tap] = (f32x2){wv[tap][e >> 1][(2 * e) & 3], wv[tap][e >> 1][(2 * e + 1) & 3]};
#pragma unroll
                    for (int i = 0; i < 5; ++i) X[i] = (f32x2){bflo(rw[i][e]), bfhi(rw[i][e])};
                    f32x2 a0 = W[4], a1 = W[4];
                    a0 = W[0] * X[0] + a0; a0 = W[1] * X[1] + a0; a0 = W[2] * X[2] + a0; a0 = W[3] * X[3] + a0;
                    a1 = W[0] * X[1] + a1; a1 = W[1] * X[2] + a1; a1 = W[2] * X[3] + a1; a1 = W[3] * X[4] + a1;
                    o0[e] = pk2(a0.x, a0.y); o1[e] = pk2(a1.x, a1.y);
                }
                *(LAS u32x4*)(lds + L_A + lt0 * A_PITCH + cv * 16) = o0;
                *(LAS u32x4*)(lds + L_A + (lt0 + 1) * A_PITCH + cv * 16) = o1;
            }
            __syncthreads();
            if (ci + 1 < NCHK) LRU_DMA_ROWS(d ? c - 1 : c + 1);
            f32x4 av[4], uv[4];
#pragma unroll
            for (int m = 0; m < 4; ++m) { av[m] = (f32x4){0.f, 0.f, 0.f, 0.f}; uv[m] = (f32x4){0.f, 0.f, 0.f, 0.f}; }
#pragma unroll
            for (int m = 0; m < 4; ++m)
#pragma unroll
                for (int kk = 0; kk < 4; ++kk) {
                    const bf16x8 a = *(const LAS bf16x8*)(lds + L_A + (m * 16 + fr) * A_PITCH + (kk * 32 + fq * 8) * 2);
                    av[m] = __builtin_amdgcn_mfma_f32_16x16x32_bf16(a, bfr[0][kk], av[m], 0, 0, 0);
                    uv[m] = __builtin_amdgcn_mfma_f32_16x16x32_bf16(a, bfr[1][kk], uv[m], 0, 0, 0);
                }
#pragma unroll
            for (int m = 0; m < 4; ++m)
#pragma unroll
                for (int jp = 0; jp < 4; jp += 2) {
                    const int tok = m * 16 + fq * 4 + jp;
                    f32x2 x;
                    x.x = __uint_as_float((unsigned)(*(const LAS unsigned short*)(lds + L_A + tok * A_PITCH + chl * 2)) << 16);
                    x.y = __uint_as_float((unsigned)(*(const LAS unsigned short*)(lds + L_A + (tok + 1) * A_PITCH + chl * 2)) << 16);
                    const f32x2 zr = {av[m][jp], av[m][jp + 1]}, zi = {uv[m][jp], uv[m][jp + 1]};
                    f32x2 ar = zr * (-1.4426950408889634f) + nba, ai_ = zi * (-1.4426950408889634f) + nbx;
                    ar = __builtin_elementwise_min(ar, (f32x2){80.f, 80.f}); ai_ = __builtin_elementwise_min(ai_, (f32x2){80.f, 80.f});
                    f32x2 e1, e2; e1.x = __builtin_amdgcn_exp2f(ar.x); e1.y = __builtin_amdgcn_exp2f(ar.y); e2.x = __builtin_amdgcn_exp2f(ai_.x); e2.y = __builtin_amdgcn_exp2f(ai_.y);
                    const f32x2 d1 = e1 + 1.f, d2 = e2 + 1.f, pr = d1 * d2;
                    f32x2 R; R.x = __builtin_amdgcn_rcpf(pr.x); R.y = __builtin_amdgcn_rcpf(pr.y);
                    const f32x2 r = R * d2, ig = R * d1;
                    const f32x2 la = r * clu;
                    f32x2 pq = la * 0.0001984127f + 0.0013888889f; pq = pq * la + 0.0083333338f; pq = pq * la + 0.041666668f; pq = pq * la + 0.16666667f; pq = pq * la + 0.5f; pq = pq * la + 1.f;
                    const f32x2 q = -(la * pq);
                    const f32x2 s2 = q * (2.f - q);
                    f32x2 mult; mult.x = __builtin_amdgcn_sqrtf(fmaxf(s2.x, 0.f)); mult.y = __builtin_amdgcn_sqrtf(fmaxf(s2.y, 0.f));
                    const f32x2 an = 1.f - q, un = mult * (ig * x);
                    av[m][jp] = an.x; av[m][jp + 1] = an.y; uv[m][jp] = un.x; uv[m][jp + 1] = un.y;
                }
            if (d == 0) lru_scan<false>(av, uv, S, fr, fq); else lru_scan<true>(av, uv, S, fr, fq);
#pragma unroll
            for (int m = 0; m < 4; ++m)
#pragma unroll
                for (int j = 0; j < 4; ++j) hbuf[(m * 16 + fq * 4 + j) * H_PITCH + chl] = uv[m][j];
            asm volatile("s_waitcnt vmcnt(0)" ::: "memory");
            __syncthreads();
#pragma unroll
            for (int tt = 0; tt < 2; ++tt) {
                const LAS float* hp = hbuf + (lt0 + tt) * H_PITCH + cv * 8;
                const f32x4 f0 = *(const LAS f32x4*)hp, f1 = *(const LAS f32x4*)(hp + 4);
                u32x4 w; const size_t o = ((size_t)(b * SEQ + c * TL + lt0 + tt)) * DM + h * 128 + cv * 8;
                if (!comb) { w.x = pk2(f0[0], f0[1]); w.y = pk2(f0[2], f0[3]); w.z = pk2(f1[0], f1[1]); w.w = pk2(f1[2], f1[3]); *(u32x4*)(HD + o) = w; }
                else {
                    const u32x4 q = ph[tt], g = gt[tt];
                    w.x = pk2((f0[0] + bflo(q.x)) * bflo(g.x), (f0[1] + bfhi(q.x)) * bfhi(g.x)); w.y = pk2((f0[2] + bflo(q.y)) * bflo(g.y), (f0[3] + bfhi(q.y)) * bfhi(g.y));
                    w.z = pk2((f1[0] + bflo(q.z)) * bflo(g.z), (f1[1] + bfhi(q.z)) * bfhi(g.z)); w.w = pk2((f1[2] + bflo(q.w)) * bflo(g.w), (f1[3] + bfhi(q.w)) * bfhi(g.w));
                    *(u32x4*)(Y + o) = w; }
            }
            if (wc_on) { wconv_store(wt, wcv); widx += ngw;
            }
        }
#undef LRU_DMA_ROWS
    }
    for (; widx < WC_END; widx += ngw) { const WcItem wt2 = wconv_decode(p, widx, lane); float v[8]; wconv_load(wt2, v); wconv_store(wt2, v); }
}
__device__ __forceinline__ void ycomb_phase(const P& p, int wv) {
    const u32x4* HF = (const u32x4*)(p.ws + WS_HF); const u32x4* HB = (const u32x4*)(p.ws + WS_HB); const u32x4* GT = (const u32x4*)(p.ws + WS_GATE);
    u32x4* Y = (u32x4*)(p.ws + WS_Y);
    const size_t n = (size_t)MTOK * DM / 8, stride = (size_t)gridDim.x * NTHREADS;
    for (size_t i = (size_t)lbid() * NTHREADS + ltid(wv); i < n; i += 4 * stride) {
        u32x4 f[4], k[4], g[4];
#pragma unroll
        for (int u = 0; u < 4; ++u) { const size_t ii = i + u * stride; if (ii < n) { f[u] = HF[ii]; k[u] = HB[ii]; g[u] = GT[ii]; } }
#pragma unroll
        for (int u = 0; u < 4; ++u) { const size_t ii = i + u * stride; if (ii < n) { u32x4 w;
#pragma unroll
            for (int e = 0; e < 4; ++e) w[e] = pk2((bflo(f[u][e]) + bflo(k[u][e])) * bflo(g[u][e]), (bfhi(f[u][e]) + bfhi(k[u][e])) * bfhi(g[u][e]));
            Y[ii] = w; } }
    }
}

__device__ __forceinline__ u32x4 rope_chunk(u32x4 w, const float (&g)[8], const float (&cs)[8], const float (&sn)[8]) {
    float v[8] = {bflo(w.x), bfhi(w.x), bflo(w.y), bfhi(w.y), bflo(w.z), bfhi(w.z), bflo(w.w), bfhi(w.w)};
    float ss = 0.f;
#pragma unroll
    for (int e = 0; e < 8; ++e) ss += v[e] * v[e];
    ss += __shfl_xor(ss, 1); ss += __shfl_xor(ss, 2); ss += __shfl_xor(ss, 4); ss += __shfl_xor(ss, 8);
    const float rs = rsqrtf(ss * (1.f / 128.f) + EPS);
    float o[8];
#pragma unroll
    for (int e = 0; e < 8; ++e) { const float y = v[e] * rs * g[e]; const float py = __shfl_xor(y, 4); o[e] = y * cs[e] + py * sn[e]; }
    u32x4 r; r.x = pk2(o[0], o[1]); r.y = pk2(o[2], o[3]); r.z = pk2(o[4], o[5]); r.w = pk2(o[6], o[7]);
    return r;
}
__device__ __forceinline__ void rope_phase(const P& p, int wave, int lane, bool dry) {
    bf16_t* Q = (bf16_t*)(p.ws + WS_Q); bf16_t* Kb = (bf16_t*)(p.ws + WS_K);
    bf16_t* Qo = dry ? (bf16_t*)(p.ws + WS_HB) : Q; bf16_t* Ko = dry ? (bf16_t*)(p.ws + WS_HB) : Kb;
    const int gw = lbid() * NWAVES + wave, ngw = gridDim.x * NWAVES;
    const int j = lane & 15, hs = lane >> 4;
    float gq[8], gk[8], inv[8];
#pragma unroll
    for (int e = 0; e < 8; ++e) { gq[e] = p.in[I_QG][8 * j + e]; gk[e] = p.in[I_KG][8 * j + e]; inv[e] = exp2f(-(float)(8 * (j & 3) + e) * (13.287712379549449f / 32.f)) * 0.15915494309189535f; }
    const float sgn = (j & 4) ? 1.f : -1.f;
    for (int tk = 2 * gw; tk < MTOK; tk += 2 * ngw) {
        u32x4 qa[2], qb[2], kk[2];
#pragma unroll
        for (int u = 0; u < 2; ++u) { const size_t tok = tk + u;
            qa[u] = *(const u32x4*)(Q + tok * DM + hs * 128 + j * 8); qb[u] = *(const u32x4*)(Q + tok * DM + 512 + hs * 128 + j * 8);
            kk[u] = *(const u32x4*)(Kb + tok * NKV + (hs & 1) * 128 + j * 8); }
#pragma unroll
        for (int u = 0; u < 2; ++u) { const size_t tok = tk + u; const int t = (int)tok & (SEQ - 1);
            const float pos = (float)(j < 8 ? (t >> 6) : (t & 63));
            float cs[8], sn[8];
#pragma unroll
            for (int e = 0; e < 8; ++e) { const float a = pos * inv[e]; cs[e] = __builtin_amdgcn_cosf(a); sn[e] = sgn * __builtin_amdgcn_sinf(a); }
            const u32x4 ra = rope_chunk(qa[u], gq, cs, sn), rb = rope_chunk(qb[u], gq, cs, sn), rk = rope_chunk(kk[u], gk, cs, sn);
            *(u32x4*)(Qo + tok * DM + hs * 128 + j * 8) = ra; *(u32x4*)(Qo + tok * DM + 512 + hs * 128 + j * 8) = rb;
            if (hs < 2) *(u32x4*)(Ko + tok * NKV + hs * 128 + j * 8) = rk; }
    }
}

__device__ __forceinline__ void rope_tile(bf16_t* base, int ld, int tok0, const float* g, int wave, int lane) {
    const int j = lane & 15, hs = lane >> 4, rr = hs >> 1, hh = hs & 1;
    float g8[8], inv[8];
#pragma unroll
    for (int e = 0; e < 8; ++e) { g8[e] = g[8 * j + e]; inv[e] = exp2f(-(float)(8 * (j & 3) + e) * (13.287712379549449f / 32.f)) * 0.15915494309189535f; }
    const float sgn = (j & 4) ? 1.f : -1.f;
    for (int it = 0; it < 16; it += 8) {
        u32x4 w[8];
#pragma unroll
        for (int u = 0; u < 8; ++u) { const int r = wave * 32 + (it + u) * 2 + rr; w[u] = *(const u32x4*)(base + (size_t)r * ld + hh * 128 + j * 8); }
#pragma unroll
        for (int u = 0; u < 8; ++u) { const int r = wave * 32 + (it + u) * 2 + rr; const int t = (tok0 + r) & (SEQ - 1);
            const float pos = (float)(j < 8 ? (t >> 6) : (t & 63));
            float cs[8], sn[8];
#pragma unroll
            for (int e = 0; e < 8; ++e) { const float a = pos * inv[e]; cs[e] = __builtin_amdgcn_cosf(a); sn[e] = sgn * __builtin_amdgcn_sinf(a); }
            *(u32x4*)(base + (size_t)r * ld + hh * 128 + j * 8) = rope_chunk(w[u], g8, cs, sn); }
    }
}

namespace attn {
constexpr int D = 128, NW = 8, QBLK = 32, KVBLK = 64;
constexpr float SCALE = 0.088388347648318440f;
constexpr float THR = 8.f;
constexpr int LDQ = DM, LDK = NKV, LDO = DM;
constexpr size_t SHM_V = KVBLK * D * 2, SHM_K = KVBLK * D * 2, SHM_ATTN = 2 * SHM_V + 2 * SHM_K + NW * 64 * 4;
#define KSWZ(row, colB) ((row) * 256 + ((colB) ^ (((row) & 7) << 4)))
#define SBAR() __builtin_amdgcn_sched_barrier(0)
__device__ __forceinline__ int crow(int r, int hi) { return (r & 3) + 8 * (r >> 2) + 4 * hi; }
__device__ __forceinline__ unsigned cvtpk(float lo, float hi) { unsigned r; asm volatile("v_cvt_pk_bf16_f32 %0, %1, %2" : "=v"(r) : "v"(lo), "v"(hi)); return r; }
__device__ __forceinline__ void partialSM(f32x16& p0, f32x16& p1, float& m_reg, float& mn, float& alpha) {
    constexpr float C = SCALE * 1.4426950408889634f;
    float pmax = p0[0]; for (int r = 1; r < 16; ++r) pmax = fmaxf(pmax, p0[r]); for (int r = 0; r < 16; ++r) pmax = fmaxf(pmax, p1[r]);
    { auto rr = __builtin_amdgcn_permlane32_swap(__float_as_uint(pmax), __float_as_uint(pmax), false, false);
      pmax = fmaxf(__uint_as_float(rr[0]), __uint_as_float(rr[1])); }
    if (__builtin_expect(__all(pmax - m_reg <= THR / SCALE), 1)) { mn = m_reg; alpha = 1.f; }
    else { mn = fmaxf(m_reg, pmax); alpha = __builtin_amdgcn_exp2f((m_reg - mn) * C); m_reg = mn; }
    float mnC = -mn * C;
    for (int r = 0; r < 16; ++r) p0[r] = fmaf(p0[r], C, mnC); for (int r = 0; r < 16; ++r) p1[r] = fmaf(p1[r], C, mnC);
    for (int r = 0; r < 16; ++r) p0[r] = __builtin_amdgcn_exp2f(p0[r]);
}
__device__ __forceinline__ void finishSM(f32x16& p0, f32x16& p1, float alpha, float& l_reg, bf16x8& pa0, bf16x8& pa1, bf16x8& pa2, bf16x8& pa3) {
    for (int r = 0; r < 16; ++r) p1[r] = __builtin_amdgcn_exp2f(p1[r]);
    float ps = 0; for (int r = 0; r < 16; ++r) ps += p0[r]; for (int r = 0; r < 16; ++r) ps += p1[r];
    { auto rr = __builtin_amdgcn_permlane32_swap(__float_as_uint(ps), __float_as_uint(ps), false, false);
      ps = __uint_as_float(rr[0]) + __uint_as_float(rr[1]); }
    l_reg = l_reg * alpha + ps;
#define PK4(P, BASE, OUT) do { unsigned a0 = cvtpk(P[BASE + 0], P[BASE + 1]), a1 = cvtpk(P[BASE + 2], P[BASE + 3]);   \
    unsigned b0 = cvtpk(P[BASE + 4], P[BASE + 5]), b1 = cvtpk(P[BASE + 6], P[BASE + 7]);                              \
    auto r0 = __builtin_amdgcn_permlane32_swap(a0, b0, false, false); auto r1 = __builtin_amdgcn_permlane32_swap(a1, b1, false, false); \
    u32x4 w = {r0[0], r1[0], r0[1], r1[1]}; OUT = *reinterpret_cast<bf16x8*>(&w); } while (0)
    PK4(p0, 0, pa0); PK4(p0, 8, pa1); PK4(p1, 0, pa2); PK4(p1, 8, pa3);
#undef PK4
}
__device__ __forceinline__ void qkt(f32x16& p0, f32x16& p1, const bf16_t* Ks, const bf16x8* qr, int r32, int hi) {
    p0 = f32x16{}; p1 = f32x16{};
    for (int d0 = 0; d0 < 8; ++d0) { int cb = (d0 * 16 + hi * 8) * 2;
        bf16x8 b0 = *reinterpret_cast<const bf16x8*>((const char*)Ks + KSWZ(r32, cb));
        bf16x8 b1 = *reinterpret_cast<const bf16x8*>((const char*)Ks + KSWZ(32 + r32, cb));
        p0 = __builtin_amdgcn_mfma_f32_32x32x16_bf16(b0, qr[d0], p0, 0, 0, 0);
        p1 = __builtin_amdgcn_mfma_f32_32x32x16_bf16(b1, qr[d0], p1, 0, 0, 0); }
}
__device__ __forceinline__ int v_st(int k, int c) { const int kk = (k & ~0xC) | ((k & 4) << 1) | ((k & 8) >> 1); return ((kk >> 3) * 4 + (c >> 5)) * 512 + ((kk & 7) * 32 + (c & 31)) * 2; }
__device__ __forceinline__ int v_rd_base(int lane) { return ((lane & 3) << 3) | (((lane >> 2) & 3) << 6) | (((lane >> 4) & 1) << 5) | (((lane >> 5) & 1) << 8); }
constexpr int v_rd_off(int d0, int ks, int half) { return d0 * 512 + ks * 4096 + half * 2048; }
template <int OFF> __device__ __forceinline__ s16x4 tr_read(int vb) {
    s16x4 r; asm volatile("ds_read_b64_tr_b16 %0, %1 offset:%2" : "=&v"(r) : "v"(vb), "i"(OFF) : "memory"); return r;
}
template <int D0> __device__ __forceinline__ void pv_one(f32x16& od, int vb, bf16x8 pa0, bf16x8 pa1, bf16x8 pa2, bf16x8 pa3) {
    const s16x4 l0 = tr_read<v_rd_off(D0, 0, 0)>(vb), h0 = tr_read<v_rd_off(D0, 0, 1)>(vb), l1 = tr_read<v_rd_off(D0, 1, 0)>(vb), h1 = tr_read<v_rd_off(D0, 1, 1)>(vb);
    const s16x4 l2 = tr_read<v_rd_off(D0, 2, 0)>(vb), h2 = tr_read<v_rd_off(D0, 2, 1)>(vb), l3 = tr_read<v_rd_off(D0, 3, 0)>(vb), h3 = tr_read<v_rd_off(D0, 3, 1)>(vb);
    asm volatile("s_waitcnt lgkmcnt(0)" ::: "memory"); SBAR();
#define PK(L, H) (bf16x8){L[0], L[1], L[2], L[3], H[0], H[1], H[2], H[3]}
    od = __builtin_amdgcn_mfma_f32_32x32x16_bf16(pa0, PK(l0, h0), od, 0, 0, 0);
    od = __builtin_amdgcn_mfma_f32_32x32x16_bf16(pa1, PK(l1, h1), od, 0, 0, 0);
    od = __builtin_amdgcn_mfma_f32_32x32x16_bf16(pa2, PK(l2, h2), od, 0, 0, 0);
    od = __builtin_amdgcn_mfma_f32_32x32x16_bf16(pa3, PK(l3, h3), od, 0, 0, 0);
#undef PK
}
__device__ __forceinline__ void pv_d0(f32x16* o, int vb, bf16x8 pa0, bf16x8 pa1, bf16x8 pa2, bf16x8 pa3) {
    pv_one<0>(o[0], vb, pa0, pa1, pa2, pa3); pv_one<1>(o[1], vb, pa0, pa1, pa2, pa3); pv_one<2>(o[2], vb, pa0, pa1, pa2, pa3); pv_one<3>(o[3], vb, pa0, pa1, pa2, pa3);
}
__device__ __forceinline__ void attn_dense_body(const bf16_t* Qb, const bf16_t* __restrict__ Kh, const bf16_t* __restrict__ Vh,
                                                bf16_t* Ob, int seq, char* lds, int wv) {
    const int tid = ltid(wv), wid = tid >> 6, lane = tid & 63, r32 = lane & 31, hi = lane >> 5;
    bf16_t* V_lds = (bf16_t*)lds; bf16_t* K_lds = (bf16_t*)(lds + 2 * SHM_V);
    float* ws = (float*)(lds + 2 * SHM_V + 2 * SHM_K) + wid * 64; float* li_l = ws; float* al_l = ws + 32;
    float m_reg = -1e30f, l_reg = 0; f32x16 o[4] = {}; bf16x8 qr[8];
    const bf16_t* Qw = Qb + (long)(wid * QBLK + r32) * LDQ + hi * 8;
#pragma unroll
    for (int d0 = 0; d0 < 8; ++d0) qr[d0] = *reinterpret_cast<const bf16x8*>(Qw + d0 * 16);
    const int sr = tid >> 4, sc = (tid & 15) * 8, vst0 = v_st(sr, sc), vst1 = v_st(32 + sr, sc);
    const int vb0 = (int)(uintptr_t)V_lds + v_rd_base(lane);
    struct { bf16x8 vs0, vs1, ks0, ks1; } sr_[2];
#define LD8(p) (*reinterpret_cast<const bf16x8*>(p))
#define SLOAD(i, k0) do { sr_[i].vs0 = LD8(&Vh[(long)((k0) + sr) * LDK + sc]); sr_[i].vs1 = LD8(&Vh[(long)((k0) + 32 + sr) * LDK + sc]); \
    sr_[i].ks0 = LD8(&Kh[(long)((k0) + sr) * LDK + sc]); sr_[i].ks1 = LD8(&Kh[(long)((k0) + 32 + sr) * LDK + sc]); } while (0)
#define SWRITE(b, i) do { *(bf16x8*)((char*)V_lds + (b) * SHM_V + vst0) = sr_[i].vs0;          \
    *(bf16x8*)((char*)V_lds + (b) * SHM_V + vst1) = sr_[i].vs1; int kc = sc * 2;               \
    *(bf16x8*)((char*)K_lds + (b) * SHM_K + KSWZ(sr, kc)) = sr_[i].ks0;                       \
    *(bf16x8*)((char*)K_lds + (b) * SHM_K + KSWZ(32 + sr, kc)) = sr_[i].ks1; } while (0)
#define SWAIT() asm volatile("s_waitcnt vmcnt(4)" ::: "memory")
#define RESC(a) do { if (__any((a) < 1.f)) { if (hi == 0) al_l[r32] = (a); asm volatile("s_waitcnt lgkmcnt(0)" ::: "memory"); \
    for (int d = 0; d < 4; ++d) for (int r = 0; r < 16; ++r) o[d][r] *= al_l[crow(r, hi)]; } } while (0)
    f32x16 pA0, pA1, pB0, pB1; float mnA, mnB, alA, alB; bf16x8 pa0, pa1, pa2, pa3; const int NT = seq / KVBLK;
    constexpr int SE = 0, SO = 1;
    SLOAD(SE, 0); asm volatile("s_waitcnt vmcnt(0)" ::: "memory"); SWRITE(0, SE); __syncthreads();
    qkt(pA0, pA1, K_lds, qr, r32, hi); partialSM(pA0, pA1, m_reg, mnA, alA);
    SLOAD(SO, KVBLK); if (2 < NT) SLOAD(SE, 2 * KVBLK);
    SWAIT(); SWRITE(1, SO); __syncthreads();
    for (int j = 1; j + 1 < NT; j += 2) {
        SBAR(); qkt(pB0, pB1, (bf16_t*)((char*)K_lds + SHM_K), qr, r32, hi);
        finishSM(pA0, pA1, alA, l_reg, pa0, pa1, pa2, pa3); SBAR();
        SLOAD(SO, (j + 2) * KVBLK); SBAR();
        pv_d0(o, vb0, pa0, pa1, pa2, pa3); partialSM(pB0, pB1, m_reg, mnB, alB);
        __syncthreads(); SWAIT(); SWRITE(0, SE);
        RESC(alB); __syncthreads();
        SBAR(); qkt(pA0, pA1, K_lds, qr, r32, hi);
        finishSM(pB0, pB1, alB, l_reg, pa0, pa1, pa2, pa3); SBAR();
        if (j + 3 < NT) SLOAD(SE, (j + 3) * KVBLK); SBAR();
        pv_d0(o, vb0 + (int)SHM_V, pa0, pa1, pa2, pa3); partialSM(pA0, pA1, m_reg, mnA, alA);
        __syncthreads(); SWAIT(); SWRITE(1, SO);
        RESC(alA); __syncthreads();
    }
    SBAR(); qkt(pB0, pB1, (bf16_t*)((char*)K_lds + SHM_K), qr, r32, hi);
    finishSM(pA0, pA1, alA, l_reg, pa0, pa1, pa2, pa3); SBAR();
    pv_d0(o, vb0, pa0, pa1, pa2, pa3); partialSM(pB0, pB1, m_reg, mnB, alB);
    __syncthreads(); RESC(alB);
    finishSM(pB0, pB1, alB, l_reg, pa0, pa1, pa2, pa3); SBAR();
    pv_d0(o, vb0 + (int)SHM_V, pa0, pa1, pa2, pa3);
    if (hi == 0) li_l[r32] = l_reg; asm volatile("s_waitcnt lgkmcnt(0)" ::: "memory");
    float rli[16];
#pragma unroll
    for (int r = 0; r < 16; ++r) rli[r] = __builtin_amdgcn_rcpf(li_l[crow(r, hi)]);
    bf16_t* Ow = Ob + (long)(wid * QBLK) * LDO;
    const int odd = lane & 1;
#pragma unroll
    for (int r = 0; r < 16; r += 2) {
#pragma unroll
        for (int d0 = 0; d0 < 4; ++d0) {
            const float m0 = o[d0][r] * rli[r], m1 = o[d0][r + 1] * rli[r + 1];
            const float snd = odd ? m0 : m1;
            const float rcv = __shfl_xor(snd, 1);
            const unsigned w = odd ? cvtpk(rcv, m1) : cvtpk(m0, rcv);
            const int orow = crow(odd ? r + 1 : r, hi);
            *(unsigned*)(Ow + (long)orow * LDO + d0 * 32 + (r32 & ~1)) = w;
        }
    }
#undef LD8
#undef SLOAD
#undef SWRITE
#undef SWAIT
#undef RESC
}
}

__device__ __forceinline__ void attn_phase(const P& p, char* lds, bool dry, int wv) {
    const bf16_t* Q = (const bf16_t*)(p.ws + WS_Q); const bf16_t* Kb = (const bf16_t*)(p.ws + WS_K); const bf16_t* Vb = (const bf16_t*)(p.ws + WS_V);
    bf16_t* O = (bf16_t*)(p.ws + (dry ? WS_HB : WS_Q));
    const int G = gridDim.x, bx = lbid();
    const int vcu = (G % 8 == 0) ? (bx % 8) * (G / 8) + bx / 8 : bx;
    for (int it = vcu; it < BATCH * 8 * 8; it += G) {
        const int grp = it >> 5, within = it & 31, b = grp >> 1, kvh = grp & 1, h = kvh * 4 + (within >> 3), qb = within & 7;
        __syncthreads();
        attn::attn_dense_body(Q + ((size_t)(b * SEQ + qb * 256)) * DM + h * 128, Kb + (size_t)b * SEQ * NKV + kvh * 128, Vb + (size_t)b * SEQ * NKV + kvh * 128,
                              O + ((size_t)(b * SEQ + qb * 256)) * DM + h * 128, SEQ, lds, wv);
    }
    __syncthreads();
}

constexpr int NPHASE = 14;
#ifndef ONLY
#define ONLY -1
#endif
#ifndef ENMASK
#define ENMASK 0x3fff
#endif
#ifndef REPMASK
#define REPMASK 0
#endif
#define EN(k) ((ONLY < 0 || ONLY == (k)) && ((ENMASK >> (k)) & 1))
typedef const __attribute__((address_space(4))) P* KP;
__device__ __forceinline__ P load_params() {
#if defined(__HIP_DEVICE_COMPILE__)
    KP kp = (KP)__builtin_amdgcn_kernarg_segment_ptr();
    asm volatile("" : "+s"(kp));
    return *kp;
#else
    return P{};
#endif
}
__global__ void __launch_bounds__(NTHREADS) mega(P parg) {
    extern __shared__ __attribute__((aligned(16))) unsigned char shm[];
    LAS unsigned char* lds = (LAS unsigned char*)shm;
    cg::grid_group grid = cg::this_grid();
    const int ph_lo = parg.ph_lo, ph_hi = parg.ph_hi;
    const int wv0 = __builtin_amdgcn_readfirstlane((int)threadIdx.x >> 6);
    if (ph_hi - ph_lo > 1) {
        volatile LAS unsigned* st = (volatile LAS unsigned*)(lds + LDS_MAIN);
        if (threadIdx.x == 0) { st[0] = 0u; st[1] = 0u; }
        __syncthreads();
        (void)xcd_barrier_post((unsigned*)(load_params().ws + WS_BAR), st);
    }
    int nseam = 0;
    for (int ph2 = 2 * ph_lo; ph2 < 2 * ph_hi; ++ph2) {
        const int ph = ph2 >> 1; const bool dry = (ph2 & 1);
        if (ph == 8 || ph == 3) continue;
        if ((ph2 & 1) && !((REPMASK >> ph) & 1)) continue;
#define WL() const int tid = ltid(wv0), wave = __builtin_amdgcn_readfirstlane(tid >> 6), lane = tid & 63; (void)lane; (void)wave
#define GW() const int gw = lbid() * NWAVES + wave, ngw = gridDim.x * NWAVES
        switch (ph) {
        case 0: if (EN(0)) { const P p = load_params(); WL(); prep_phase(p, lds, wave, lane); } break;
        case 1: if (EN(1)) { const P p = load_params(); unsigned char* ws = p.ws;
                  pg8::Gemm g{(const bf16_t*)(ws + WS_HN), (const bf16_t*)(ws + WS_WIN), MTOK, 2 * DM, DM}; pg8::StaticOrder S; S.init(MTOK, 2 * DM, gridDim.x, lbid());
                  pg8::EpiWin E{(bf16_t*)(ws + WS_GATE), (bf16_t*)(ws + WS_RECPRE), (const float*)(ws + WS_PART)}; pg8::gemm_phase(lds, g, S, E, wv0); } break;
        case 2: if (EN(2)) { const P p = load_params(); lru_phase(p, lds, wv0); } break;
        case 3: if (EN(3)) { const P p = load_params(); ycomb_phase(p, wv0); } break;
        case 4: case 6: case 10: case 12: if (EN(4)) {
            const P p = load_params(); unsigned char* ws = p.ws;
            const bf16_t* A = (const bf16_t*)(ws + (ph == 4 ? WS_Y : (ph == 10 ? WS_Q : WS_U)));
            const bf16_t* Bt = (const bf16_t*)(ws + (ph == 4 ? WS_WOUT : ph == 6 ? WS_WDN0 : ph == 10 ? WS_WO : WS_WDN1));
            const int K = (ph == 6 || ph == 12) ? DFF : DM;
            pg8::Gemm g{A, Bt, MTOK, DM, K}; pg8::StaticOrder S; S.init(MTOK, DM, gridDim.x, lbid());
            pg8::EpiResid E{(bf16_t*)(ws + (dry ? WS_HB : WS_HN)), (float*)(ws + (dry ? WS_HB : WS_PART)), ph != 12}; pg8::gemm_phase(lds, g, S, E, wv0); } break;
        case 5: case 11: if (EN(5)) {
            const P p = load_params(); unsigned char* ws = p.ws;
            pg8::Gemm g{(const bf16_t*)(ws + WS_HN), (const bf16_t*)(ws + (ph == 5 ? WS_WUP0 : WS_WUP1)), MTOK, DFF, DM}; pg8::StaticOrder S; S.init(MTOK, DFF, gridDim.x, lbid());
            pg8::EpiRelu2 E{(bf16_t*)(ws + WS_U), (const float*)(ws + WS_PART)}; pg8::gemm_phase(lds, g, S, E, wv0); } break;
        case 7: if (EN(7)) { const P p = load_params(); unsigned char* ws = p.ws;
                  pg8::Gemm g{(const bf16_t*)(ws + WS_HN), (const bf16_t*)(ws + WS_WQKV), MTOK, NQKV, DM}; pg8::StaticOrder S; S.init(MTOK, NQKV, gridDim.x, lbid());
                  pg8::EpiQKV E{ws, (const float*)(ws + WS_PART)}; pg8::gemm_phase(lds, g, S, E, wv0);
                  asm volatile("s_waitcnt vmcnt(0)" ::: "memory"); __syncthreads(); __builtin_amdgcn_fence(__ATOMIC_ACQUIRE, "agent"); asm volatile("s_waitcnt vmcnt(0)" ::: "memory");
                  pg8::Unit u; WL();
                  for (int i = 0; S.next(i, u); ++i) { if (u.pn < 4) rope_tile((bf16_t*)(ws + WS_Q) + (size_t)u.pm * 256 * DM + u.pn * 256, DM, u.pm * 256, p.in[I_QG], wave, lane);
                      else if (u.pn == 4) rope_tile((bf16_t*)(ws + WS_K) + (size_t)u.pm * 256 * NKV, NKV, u.pm * 256, p.in[I_KG], wave, lane); } } break;
        case 8: if (EN(8)) { const P p = load_params(); WL(); rope_phase(p, wave, lane, dry); } break;
        case 9: if (EN(9)) { const P p = load_params(); attn_phase(p, (char*)shm, dry, wv0); } break;
        case 13: if (EN(13)) { const P p = load_params(); WL(); GW(); final_norm_rows((const bf16_t*)(p.ws + WS_HN), p.in[I_FG], p.out, gw, ngw, lane); } break;
        default: break;
        }
        if ((((ph2 & 1) == 0) && ((REPMASK >> ph) & 1)) || ph + 1 < ph_hi) { if (ph_hi < 0) grid.sync();   { XcdBarrier xb2; xb2.bar = (unsigned*)(load_params().ws + WS_BAR); xb2.x = xb_xcc_id(); xb2.st = (volatile LAS unsigned*)(lds + LDS_MAIN); xcd_barrier(xb2, wv0); } ++nseam; }
    }
}

extern "C" void kernel_launch(void* const* d_in, const int* in_sizes, int n_in, void* d_out, int out_size, void* d_ws, size_t ws_size, hipStream_t stream) {
    static int grid = 0;
    if (grid == 0) {
        if (n_in != 19 || out_size != MTOK * DM || ws_size < WS_END) { fprintf(stderr, "kernel_launch: unexpected shapes n_in %d out %d ws %zu\n", n_in, out_size, ws_size); grid = -1; return; }
        int dev = 0, cus = 0, per_cu = 0;
        hipGetDevice(&dev);
        hipDeviceGetAttribute(&cus, hipDeviceAttributeMultiprocessorCount, dev);
        if (hipFuncSetAttribute((const void*)mega, hipFuncAttributeMaxDynamicSharedMemorySize, LDS_BYTES) != hipSuccess) { fprintf(stderr, "kernel_launch: hipFuncSetAttribute failed\n"); grid = -1; return; }
        hipOccupancyMaxActiveBlocksPerMultiprocessor(&per_cu, (const void*)mega, NTHREADS, LDS_BYTES);
        if (per_cu < 1) per_cu = 1;
        grid = cus * per_cu;
        (void)hipGetLastError();
    }
    if (grid < 0) return;
    P p{};
    for (int i = 0; i < 19; ++i) p.in[i] = (const float*)d_in[i];
    p.out = (float*)d_out; p.ws = (unsigned char*)d_ws;
#if ONE_LAUNCH
    p.ph_lo = 0; p.ph_hi = NPHASE;
    if (hipMemsetAsync((char*)d_ws + WS_BAR, 0, XCD_BAR_WORDS * 4, stream) != hipSuccess) { fprintf(stderr, "kernel_launch: memset of the barrier words failed\n"); return; }
    void* args[] = {&p};
    hipError_t e = hipLaunchCooperativeKernel((const void*)mega, dim3(grid), dim3(NTHREADS), args, LDS_BYTES, stream);
    if (e != hipSuccess) fprintf(stderr, "cooperative launch failed: %s (grid %d)\n", hipGetErrorString(e), grid);
#else
    for (int ph = 0; ph < NPHASE; ++ph) {
        p.ph_lo = ph; p.ph_hi = ph + 1;
        hipLaunchKernelGGL(mega, dim3(grid), dim3(NTHREADS), LDS_BYTES, stream, p);
    }
#endif
}
```

```cpp
#include <hip/hip_runtime.h>
#include <hip/hip_cooperative_groups.h>
#include <cstdio>
#include <cstdint>
namespace cg = cooperative_groups;

#ifndef ONE_LAUNCH
#define ONE_LAUNCH 1
#endif

#define LAS __attribute__((address_space(3)))
typedef unsigned short bf16_t;
typedef short bf16x8 __attribute__((ext_vector_type(8)));
typedef short s16x4 __attribute__((ext_vector_type(4)));
typedef float f32x4 __attribute__((ext_vector_type(4)));
typedef float f32x2 __attribute__((ext_vector_type(2)));
typedef float f32x16 __attribute__((ext_vector_type(16)));
typedef unsigned u32x4 __attribute__((ext_vector_type(4)));
typedef unsigned u32x2 __attribute__((ext_vector_type(2)));

constexpr int BATCH = 16, SEQ = 2048, DM = 1024, MTOK = BATCH * SEQ, DFF = 4096, NQKV = 1536, NKV = 256;
constexpr float EPS = 1e-6f;
constexpr int NTHREADS = 512, NWAVES = 8;
constexpr int LDS_MAIN = 131072;
constexpr int LDS_RS = LDS_MAIN + 16;
constexpr int LDS_BYTES = LDS_RS + 2048;

constexpr size_t MiB = 1024 * 1024;
constexpr size_t WS_WIN = 0, WS_WOUT = 4 * MiB, WS_WQKV = 6 * MiB, WS_WO = 9 * MiB, WS_WUP0 = 11 * MiB, WS_WUP1 = 19 * MiB,
                 WS_WDN0 = 27 * MiB, WS_WDN1 = 35 * MiB, WS_WG = 43 * MiB, WS_PART = 44 * MiB, WS_BAR = 46 * MiB, WS_HN = 48 * MiB, WS_U = 112 * MiB;
constexpr size_t WS_GATE = WS_U, WS_RECPRE = WS_U + 64 * MiB, WS_Y = WS_U + 128 * MiB, WS_HF = WS_U + 192 * MiB, WS_HB = WS_U + 256 * MiB;
constexpr size_t WS_Q = WS_U, WS_K = WS_U + 64 * MiB, WS_V = WS_U + 80 * MiB;
constexpr size_t WS_END = WS_U + 320 * MiB;

struct P {
    const float* in[19];
    float* out;
    unsigned char* ws;
    int ph_lo, ph_hi;
};
enum { I_X = 0, I_GMIX, I_GMLP, I_WIN, I_CONVW, I_CONVB, I_WA, I_BA, I_WX, I_BX, I_LAM, I_WOUT, I_WQKV, I_QG, I_KG, I_WO, I_WUP, I_WDN, I_FG };

__device__ __forceinline__ int ltid(int wv) { int t = wv * 64 + (int)__builtin_amdgcn_mbcnt_hi(~0u, __builtin_amdgcn_mbcnt_lo(~0u, 0u)); asm volatile("" : "+v"(t)); return t; }
__device__ __forceinline__ int lbid() { int b = blockIdx.x; asm volatile("" : "+s"(b)); return b; }
__device__ __forceinline__ unsigned pk2(float lo, float hi) { unsigned r; asm("v_cvt_pk_bf16_f32 %0, %1, %2" : "=v"(r) : "v"(lo), "v"(hi)); return r; }
__device__ __forceinline__ float bflo(unsigned w) { return __uint_as_float(w << 16); }
__device__ __forceinline__ float bfhi(unsigned w) { return __uint_as_float(w & 0xffff0000u); }
template <int K> __device__ __forceinline__ float lane_xor(float v) { return __int_as_float(__builtin_amdgcn_ds_swizzle(__float_as_int(v), (K << 10) | 0x1f)); }
__device__ __forceinline__ float sum_xor32(float v) { auto rr = __builtin_amdgcn_permlane32_swap(__float_as_uint(v), __float_as_uint(v), false, false); return __uint_as_float(rr[0]) + __uint_as_float(rr[1]); }
__device__ __forceinline__ float wave_sum(float v) {
    v += lane_xor<1>(v); v += lane_xor<2>(v); v += lane_xor<4>(v); v += lane_xor<8>(v); v += lane_xor<16>(v);
    return sum_xor32(v);
}
__device__ __forceinline__ float fsigmoid(float z) { return __builtin_amdgcn_rcpf(1.0f + __builtin_amdgcn_exp2f(-1.4426950408889634f * z)); }

namespace pg8 {
constexpr int BM = 256, BK = 64, HALF = 128, HTB = HALF * BK * 2, STAGE_BYTES = 8 * HTB, NXCD = 8, WGM = 8;
__host__ __device__ __forceinline__ int lds_byte(int r, int c) { const int st = (r >> 4) * 2 + (c >> 5), rr = r & 15, cc = c & 31, ob = rr * 64 + cc * 2; return st * 1024 + (ob ^ (((ob >> 9) & 1) << 5)); }
__host__ __device__ __forceinline__ void stage_rc(int b, int& R, int& C) { const int st = b / 1024, sb = b % 1024, swz = sb ^ (((sb >> 9) & 1) << 5); R = (st >> 1) * 16 + swz / 64; C = (st & 1) * 32 + (swz % 64) / 2; }
__host__ __device__ __forceinline__ int perm32(int rho) { const int n = rho >> 4, i = rho & 15; return 8 * (i >> 2) + 4 * n + (i & 3); }
struct Unit { int pm, pn; };
struct Gemm { const bf16_t* A; const bf16_t* Bt; int M, N, K; };
struct StaticOrder {
    int nM, nN, nwg, G, c;
    __device__ void init(int M, int N, int G_, int c_) { nM = M / BM; nN = N / BM; nwg = nM * nN; G = G_; c = c_; }
    __device__ bool next(int i, Unit& u) const {
        const long L = (long)i * G + c; if (L >= nwg) return false;
        int wgid = (int)L; { const int q = nwg / NXCD, r = nwg % NXCD, xcd = wgid % NXCD, off = wgid / NXCD; wgid = (xcd < r ? xcd * (q + 1) : r * (q + 1) + (xcd - r) * q) + off; }
        const int nig = WGM * nN, gid = wgid / nig, fm = gid * WGM, gsz = (nM - fm) < WGM ? (nM - fm) : WGM;
        u.pm = fm + ((wgid % nig) % gsz); u.pn = (wgid % nig) / gsz; return true;
    }
};

__device__ __forceinline__ void row_scales_load(const float* part, int row0, int fq, f32x4 (&t)[2][4]);
__device__ __forceinline__ void row_scales_reduce(const f32x4 (&t)[2][4], float (&rs)[2][4]);
template <class Epi>
__device__ __forceinline__ void gemm_phase(LAS unsigned char* lds, const Gemm g, const StaticOrder& S, const Epi& E, int wv) {
    const int tid = ltid(wv), wid = __builtin_amdgcn_readfirstlane(tid >> 6), lane = tid & 63, wr = wid >> 2, wc = wid & 3, fr = lane & 15, fq = lane >> 4;
    const int K = g.K, nt = K / BK;
    unsigned voffA[2], voffB[2];
#pragma unroll
    for (int i = 0; i < 2; ++i) { int R, C; stage_rc(tid * 16 + i * 8192, R, C); const int Rb = Epi::PERM ? ((R & ~31) + perm32(R & 31)) : R;
        voffA[i] = (unsigned)(R * K + C) * 2u; voffB[i] = (unsigned)(Rb * K + C) * 2u; }
    const size_t kstep = (size_t)(BK * 2);
    const size_t hstep = (size_t)HALF * K * 2;
    const size_t tstep = 2 * hstep;
    const unsigned ldsw = (unsigned)wid * 1024u;
    const int aoff = lds_byte(wr * 64 + fr, fq * 8), boff = lds_byte(wc * 32 + fr, fq * 8);
#define PG8_SA(b, h) (((b) * 2 + (h)) * HTB)
#define PG8_SB(b, h) ((4 + (b) * 2 + (h)) * HTB)
#define PG8_STAGE(bufoff, gbase, voff) do { _Pragma("unroll") for (int _i = 0; _i < 2; ++_i) \
        __builtin_amdgcn_global_load_lds((const unsigned*)((const char*)(gbase) + (voff)[_i]), (LAS unsigned*)(lds + (bufoff) + ldsw + _i * 8192), 16, 0, 0); } while (0)
#define PG8_LDA(dst, b, h) do { _Pragma("unroll") for (int m = 0; m < 4; ++m) _Pragma("unroll") for (int k = 0; k < 2; ++k) dst[m][k] = *(const LAS bf16x8*)(lds + PG8_SA(b, h) + aoff + m * 2048 + k * 1024); } while (0)
#define PG8_LDB(dst, b, h) do { _Pragma("unroll") for (int n = 0; n < 2; ++n) _Pragma("unroll") for (int k = 0; k < 2; ++k) dst[n][k] = *(const LAS bf16x8*)(lds + PG8_SB(b, h) + boff + n * 2048 + k * 1024); } while (0)
#define PG8_MMA(ai, bj, At, Bt) do { __builtin_amdgcn_s_setprio(1); _Pragma("unroll") for (int m = 0; m < 4; ++m) _Pragma("unroll") for (int n = 0; n < 2; ++n) _Pragma("unroll") for (int k = 0; k < 2; ++k) \
        acc[ai][bj][m][n] = __builtin_amdgcn_mfma_f32_16x16x32_bf16(Bt[n][k], At[m][k], acc[ai][bj][m][n], 0, 0, 0); __builtin_amdgcn_s_setprio(0); } while (0)
#define PG8_WAIT_V(n) asm volatile("s_waitcnt vmcnt(" #n ")" ::: "memory")
#define PG8_WAIT_L(n) asm volatile("s_waitcnt lgkmcnt(" #n ")" ::: "memory")
#define PG8_BAR __builtin_amdgcn_s_barrier()
#define PG8_SCHED __builtin_amdgcn_sched_barrier(0)
    Unit cur, nxt; int ui = 0;
    if (!S.next(0, cur)) return;
    f32x4 acc[2][2][4][2];
#pragma unroll
    for (int a = 0; a < 2; ++a)
#pragma unroll
        for (int b = 0; b < 2; ++b)
#pragma unroll
            for (int m = 0; m < 4; ++m)
#pragma unroll
                for (int n = 0; n < 2; ++n) acc[a][b][m][n] = (f32x4){0.f, 0.f, 0.f, 0.f};
    bf16x8 At[4][2], B0[2][2], B1[2][2];
    const char* cA = (const char*)g.A + (size_t)cur.pm * tstep; const char* cB = (const char*)g.Bt + (size_t)cur.pn * tstep;
    LAS float* rsl = (LAS float*)(lds + LDS_RS);
#define PG8_RS_LOAD(pm_, ta, tb) do { const float* _pp = E.part + ((size_t)(pm_) * BM + wid * 32 + (lane >> 1)) * 16 + (lane & 1) * 8; ta = *(const f32x4*)_pp; tb = *(const f32x4*)(_pp + 4); } while (0)
#define PG8_RS_PUBLISH(ta, tb, par) do { float _ss = ((ta[0] + ta[1]) + (ta[2] + ta[3])) + ((tb[0] + tb[1]) + (tb[2] + tb[3])); _ss += lane_xor<1>(_ss); \
        if (!(lane & 1)) rsl[(par) * 256 + wid * 32 + (lane >> 1)] = rsqrtf(_ss * (1.f / DM) + EPS); } while (0)
    f32x4 ta0, tb0; if constexpr (Epi::ROWSCALE) PG8_RS_LOAD(cur.pm, ta0, tb0);
    PG8_STAGE(PG8_SB(0, 0), cB, voffB); PG8_STAGE(PG8_SA(0, 0), cA, voffA); PG8_STAGE(PG8_SB(0, 1), cB + hstep, voffB); PG8_STAGE(PG8_SA(0, 1), cA + hstep, voffA);
    if (wr == 1) PG8_BAR;
    PG8_WAIT_V(4); PG8_BAR;
    PG8_STAGE(PG8_SB(1, 0), cB + kstep, voffB); PG8_STAGE(PG8_SA(1, 0), cA + kstep, voffA); PG8_STAGE(PG8_SB(1, 1), cB + hstep + kstep, voffB);
    PG8_WAIT_V(6); PG8_BAR;
    if constexpr (Epi::ROWSCALE) PG8_RS_PUBLISH(ta0, tb0, 0);
    for (;;) {
        const bool has_next = S.next(ui + 1, nxt);
        const char* nA = has_next ? (const char*)g.A + (size_t)nxt.pm * tstep : cA; const char* nB = has_next ? (const char*)g.Bt + (size_t)nxt.pn * tstep : cB;
        for (int t = 0; t < nt; t += 2) {
            const bool last = (t == nt - 2);
            const char* a1 = cA + (size_t)(t + 1) * kstep;
            const char* a2 = last ? nA : cA + (size_t)(t + 2) * kstep; const char* b2 = last ? nB : cB + (size_t)(t + 2) * kstep;
            const char* a3 = a2 + kstep; const char* b3 = b2 + kstep;
            PG8_LDB(B0, 0, 0); PG8_SCHED; PG8_LDA(At, 0, 0); PG8_STAGE(PG8_SA(1, 1), a1 + hstep, voffA);
            PG8_WAIT_L(8); PG8_BAR; PG8_WAIT_L(0); PG8_MMA(0, 0, At, B0); PG8_BAR; PG8_SCHED;
            PG8_LDB(B1, 0, 1); PG8_STAGE(PG8_SB(0, 0), b2, voffB);
            PG8_BAR; PG8_WAIT_L(0); PG8_MMA(0, 1, At, B1); PG8_BAR;
            PG8_LDA(At, 0, 1); PG8_STAGE(PG8_SA(0, 0), a2, voffA);
            PG8_BAR; PG8_WAIT_L(0); PG8_MMA(1, 0, At, B0); PG8_BAR; PG8_SCHED;
            PG8_STAGE(PG8_SB(0, 1), b2 + hstep, voffB);
            PG8_WAIT_V(6); PG8_BAR; PG8_MMA(1, 1, At, B1); PG8_BAR;
            PG8_LDB(B0, 1, 0); PG8_SCHED; PG8_LDA(At, 1, 0); PG8_STAGE(PG8_SA(0, 1), a2 + hstep, voffA);
            PG8_WAIT_L(8); PG8_BAR; PG8_WAIT_L(0); PG8_MMA(0, 0, At, B0); PG8_BAR; PG8_SCHED;
            PG8_LDB(B1, 1, 1); PG8_STAGE(PG8_SB(1, 0), b3, voffB);
            PG8_BAR; PG8_WAIT_L(0); PG8_MMA(0, 1, At, B1); PG8_BAR;
            PG8_LDA(At, 1, 1); PG8_STAGE(PG8_SA(1, 0), a3, voffA);
            PG8_BAR; PG8_WAIT_L(0); PG8_MMA(1, 0, At, B0); PG8_BAR; PG8_SCHED;
            PG8_STAGE(PG8_SB(1, 1), b3 + hstep, voffB);
            PG8_WAIT_V(6); PG8_BAR; PG8_MMA(1, 1, At, B1); PG8_BAR;
        }
        if constexpr (Epi::ROWSCALE) { f32x4 ta, tb; if (has_next) PG8_RS_LOAD(nxt.pm, ta, tb);
            E(acc, cur, wr, wc, fr, fq, rsl + (ui & 1) * 256); if (has_next) PG8_RS_PUBLISH(ta, tb, (ui + 1) & 1); }
        else E(acc, cur, wr, wc, fr, fq, rsl);
        if (!has_next) break;
#pragma unroll
        for (int a = 0; a < 2; ++a)
#pragma unroll
            for (int b = 0; b < 2; ++b)
#pragma unroll
                for (int m = 0; m < 4; ++m)
#pragma unroll
                    for (int n = 0; n < 2; ++n) acc[a][b][m][n] = (f32x4){0.f, 0.f, 0.f, 0.f};
        cur = nxt; cA = nA; cB = nB; ++ui;
    }
    PG8_WAIT_V(0);
    if (wr == 0) PG8_BAR;
    PG8_BAR;
#undef PG8_RS_PUBLISH
#undef PG8_RS_LOAD
#undef PG8_SA
#undef PG8_SB
#undef PG8_STAGE
#undef PG8_LDA
#undef PG8_LDB
#undef PG8_MMA
#undef PG8_WAIT_V
#undef PG8_WAIT_L
#undef PG8_BAR
#undef PG8_SCHED
}

__device__ __forceinline__ float gelu_tanh(float x) {
    const float y = 1.5957691216057308f * (x + 0.044715f * x * x * x);
    return x * fsigmoid(y);
}
template <int MODE> __device__ __forceinline__ void store8(bf16_t* p, f32x4 v0, f32x4 v1, float rs) {
    f32x2 a = {v0[0], v0[1]}, b = {v0[2], v0[3]}, c = {v1[0], v1[1]}, d = {v1[2], v1[3]};
    a = a * rs; b = b * rs; c = c * rs; d = d * rs;
    if (MODE == 1) {
        a.x = gelu_tanh(a.x); a.y = gelu_tanh(a.y); b.x = gelu_tanh(b.x); b.y = gelu_tanh(b.y); c.x = gelu_tanh(c.x); c.y = gelu_tanh(c.y); d.x = gelu_tanh(d.x); d.y = gelu_tanh(d.y);
    }
    if (MODE == 2) {
        const f32x2 z = {0.f, 0.f};
        a = __builtin_elementwise_max(a, z); b = __builtin_elementwise_max(b, z); c = __builtin_elementwise_max(c, z); d = __builtin_elementwise_max(d, z);
        a = a * a; b = b * b; c = c * c; d = d * d;
    }
    u32x4 w; w.x = pk2(a.x, a.y); w.y = pk2(b.x, b.y); w.z = pk2(c.x, c.y); w.w = pk2(d.x, d.y);
    *(u32x4*)p = w;
}
__device__ __forceinline__ float row_rs(const float* part, int row) {
    const f32x4* pp = (const f32x4*)(part + (size_t)row * 16); const f32x4 a = pp[0], b = pp[1], c = pp[2], d = pp[3];
    const float ss = ((a[0] + a[1]) + (a[2] + a[3])) + ((b[0] + b[1]) + (b[2] + b[3])) + ((c[0] + c[1]) + (c[2] + c[3])) + ((d[0] + d[1]) + (d[2] + d[3]));
    return rsqrtf(ss * (1.f / DM) + EPS);
}
__device__ __forceinline__ void row_scales_load(const float* part, int row0, int fq, f32x4 (&t)[2][4]) {
#pragma unroll
    for (int ai = 0; ai < 2; ++ai)
#pragma unroll
        for (int m = 0; m < 4; ++m) t[ai][m] = *(const f32x4*)(part + (size_t)(row0 + ai * HALF + m * 16) * 16 + fq * 4);
}
__device__ __forceinline__ void row_scales_reduce(const f32x4 (&t)[2][4], float (&rs)[2][4]) {
#pragma unroll
    for (int ai = 0; ai < 2; ++ai)
#pragma unroll
        for (int m = 0; m < 4; ++m) { float ss = (t[ai][m][0] + t[ai][m][1]) + (t[ai][m][2] + t[ai][m][3]); ss += lane_xor<16>(ss); ss = sum_xor32(ss); rs[ai][m] = rsqrtf(ss * (1.f / DM) + EPS); }
}
struct EpiWin {
    static constexpr bool PERM = true, ROWSCALE = true;
    bf16_t* gate; bf16_t* rec; const float* part;
    __device__ __forceinline__ void operator()(const f32x4 (&acc)[2][2][4][2], const Unit& u, int wr, int wc, int fr, int fq, const LAS float* rsl) const {
        const int row0 = u.pm * BM + wr * 64 + fr; const bool isg = u.pn < 4; bf16_t* base = isg ? gate : rec;
        const int col0 = (u.pn & 3) * BM + wc * 32 + 8 * fq;
#pragma unroll
        for (int ai = 0; ai < 2; ++ai)
#pragma unroll
            for (int m = 0; m < 4; ++m) { bf16_t* rowp = base + (size_t)(row0 + ai * HALF + m * 16) * DM + col0; const float rs = rsl[ai * HALF + wr * 64 + m * 16 + fr];
#pragma unroll
                for (int bj = 0; bj < 2; ++bj) { if (isg) store8<1>(rowp + bj * HALF, acc[ai][bj][m][0], acc[ai][bj][m][1], rs); else store8<0>(rowp + bj * HALF, acc[ai][bj][m][0], acc[ai][bj][m][1], rs); } }
    }
};
struct EpiRelu2 {
    static constexpr bool PERM = true, ROWSCALE = true;
    bf16_t* U; const float* part;
    __device__ __forceinline__ void operator()(const f32x4 (&acc)[2][2][4][2], const Unit& u, int wr, int wc, int fr, int fq, const LAS float* rsl) const {
        const int row0 = u.pm * BM + wr * 64 + fr; const int col0 = u.pn * BM + wc * 32 + 8 * fq;
#pragma unroll
        for (int ai = 0; ai < 2; ++ai)
#pragma unroll
            for (int m = 0; m < 4; ++m) { const int row = row0 + ai * HALF + m * 16; bf16_t* rowp = U + (size_t)row * DFF + col0;
                const float rs = rsl[ai * HALF + wr * 64 + m * 16 + fr];
#pragma unroll
                for (int bj = 0; bj < 2; ++bj) store8<2>(rowp + bj * HALF, acc[ai][bj][m][0], acc[ai][bj][m][1], rs); }
    }
};
struct EpiQKV {
    static constexpr bool PERM = true, ROWSCALE = true;
    unsigned char* ws; const float* part;
    __device__ __forceinline__ void operator()(const f32x4 (&acc)[2][2][4][2], const Unit& u, int wr, int wc, int fr, int fq, const LAS float* rsl) const {
        const int row0 = u.pm * BM + wr * 64 + fr;
        const bool isq = u.pn < 4; bf16_t* base = (bf16_t*)(ws + WS_Q + (isq ? (size_t)0 : (size_t)(64 + 16 * (u.pn - 4)) * MiB)); const int ldc = isq ? DM : NKV; const int colt = isq ? u.pn * BM : 0;
        const int col0 = colt + wc * 32 + 8 * fq;
#pragma unroll
        for (int ai = 0; ai < 2; ++ai)
#pragma unroll
            for (int m = 0; m < 4; ++m) { const int row = row0 + ai * HALF + m * 16; bf16_t* rowp = base + (size_t)row * ldc + col0;
                const float rs = rsl[ai * HALF + wr * 64 + m * 16 + fr];
#pragma unroll
                for (int bj = 0; bj < 2; ++bj) store8<0>(rowp + bj * HALF, acc[ai][bj][m][0], acc[ai][bj][m][1], rs); }
    }
};
struct EpiResid {
    static constexpr bool PERM = true, ROWSCALE = false;
    bf16_t* xb; float* part; int stats;
    __device__ __forceinline__ void operator()(const f32x4 (&acc)[2][2][4][2], const Unit& u, int wr, int wc, int fr, int fq, const LAS float* rsl) const {
        const int row0 = u.pm * BM + wr * 64 + fr, col0 = u.pn * BM + wc * 32 + 8 * fq;
        u32x4 bsa[2][4][2];
#pragma unroll
        for (int ai = 0; ai < 2; ++ai)
#pragma unroll
            for (int m = 0; m < 4; ++m)
#pragma unroll
                for (int bj = 0; bj < 2; ++bj) bsa[ai][m][bj] = *(const u32x4*)(xb + (size_t)(row0 + ai * HALF + m * 16) * DM + col0 + bj * HALF);
        asm volatile("" ::: "memory");
#pragma unroll
        for (int ai = 0; ai < 2; ++ai)
#pragma unroll
            for (int m = 0; m < 4; ++m) { const int row = row0 + ai * HALF + m * 16; bf16_t* rowp = xb + (size_t)row * DM + col0;
                float ss = 0.f;
#pragma unroll
                for (int bj = 0; bj < 2; ++bj) { const u32x4 b = bsa[ai][m][bj]; const f32x4 a0 = acc[ai][bj][m][0], a1 = acc[ai][bj][m][1];
                    const float v0 = bflo(b.x) + a0[0], v1 = bfhi(b.x) + a0[1], v2 = bflo(b.y) + a0[2], v3 = bfhi(b.y) + a0[3];
                    const float v4 = bflo(b.z) + a1[0], v5 = bfhi(b.z) + a1[1], v6 = bflo(b.w) + a1[2], v7 = bfhi(b.w) + a1[3];
                    ss += ((v0 * v0 + v1 * v1) + (v2 * v2 + v3 * v3)) + ((v4 * v4 + v5 * v5) + (v6 * v6 + v7 * v7));
                    u32x4 w; w.x = pk2(v0, v1); w.y = pk2(v2, v3); w.z = pk2(v4, v5); w.w = pk2(v6, v7);
                    *(u32x4*)(rowp + bj * HALF) = w; }
                if (stats) { ss += lane_xor<16>(ss); ss = sum_xor32(ss); if (fq == 0) part[(size_t)row * 16 + u.pn * 4 + wc] = ss; } }
    }
};
}

__device__ __forceinline__ void transpose_item(const float* W, int K, int N, bf16_t* WT, int row_off, LAS float* scr, int item, int lane, const float* gk = nullptr) {
    const int nblk = N / 32, kb = item / nblk, nb = item % nblk, k0 = 64 * kb, n0 = 32 * nb;
    float tv[32];
#pragma unroll
    for (int i = 0; i < 32; ++i) tv[i] = W[(size_t)(k0 + 2 * i + (lane >> 5)) * N + n0 + (lane & 31)];
#pragma unroll
    for (int i = 0; i < 32; ++i) scr[(2 * i + (lane >> 5)) * 33 + (lane & 31)] = tv[i];
    asm volatile("s_waitcnt lgkmcnt(0)" ::: "memory");
    const int c = lane & 7;
#pragma unroll
    for (int j = 0; j < 4; ++j) { const int n = (lane >> 3) + 8 * j; const LAS float* s = scr + (8 * c) * 33 + n;
        f32x4 g0 = (f32x4){1.f, 1.f, 1.f, 1.f}, g1 = g0; if (gk) { g0 = *(const f32x4*)(gk + k0 + 8 * c); g1 = *(const f32x4*)(gk + k0 + 8 * c + 4); }
        u32x4 o; o.x = pk2(s[0 * 33] * g0[0], s[1 * 33] * g0[1]); o.y = pk2(s[2 * 33] * g0[2], s[3 * 33] * g0[3]); o.z = pk2(s[4 * 33] * g1[0], s[5 * 33] * g1[1]); o.w = pk2(s[6 * 33] * g1[2], s[7 * 33] * g1[3]);
        *(u32x4*)(WT + (size_t)(row_off + n0 + n) * K + k0 + 8 * c) = o; }
    asm volatile("s_waitcnt lgkmcnt(0)" ::: "memory");
}
__device__ __forceinline__ void norm_rows_bf16(const float* src, const float* g, bf16_t* dst, int gw, int ngw, int lane) {
    f32x4 gv[4];
#pragma unroll
    for (int j = 0; j < 4; ++j) gv[j] = *((const f32x4*)g + lane + 64 * j);
    for (int m = gw; m < MTOK; m += ngw) {
        const f32x4* xr = (const f32x4*)(src + (size_t)m * DM) + lane;
        f32x4 v[4]; float s = 0.f;
#pragma unroll
        for (int j = 0; j < 4; ++j) { v[j] = xr[64 * j]; s += (v[j].x * v[j].x + v[j].y * v[j].y) + (v[j].z * v[j].z + v[j].w * v[j].w); }
        const float rs = rsqrtf(wave_sum(s) * (1.f / DM) + EPS);
        u32x2* o8 = (u32x2*)(dst + (size_t)m * DM) + lane;
#pragma unroll
        for (int j = 0; j < 4; ++j) { u32x2 w; w.x = pk2(v[j].x * rs * gv[j].x, v[j].y * rs * gv[j].y); w.y = pk2(v[j].z * rs * gv[j].z, v[j].w * rs * gv[j].w); o8[64 * j] = w; }
    }
}
__device__ __forceinline__ void xb_rows(const float* src, bf16_t* dst, float* part, int gw, int ngw, int lane) {
    for (int m = 4 * gw; m < MTOK; m += 4 * ngw) {
        f32x4 v[4][4];
#pragma unroll
        for (int u = 0; u < 4; ++u)
#pragma unroll
            for (int j = 0; j < 4; ++j) v[u][j] = *((const f32x4*)(src + (size_t)(m + u) * DM) + lane + 64 * j);
#pragma unroll
        for (int u = 0; u < 4; ++u) {
            float s = 0.f;
#pragma unroll
            for (int j = 0; j < 4; ++j) s += (v[u][j].x * v[u][j].x + v[u][j].y * v[u][j].y) + (v[u][j].z * v[u][j].z + v[u][j].w * v[u][j].w);
            s = wave_sum(s);
            u32x2* o8 = (u32x2*)(dst + (size_t)(m + u) * DM) + lane;
#pragma unroll
            for (int j = 0; j < 4; ++j) { u32x2 w; w.x = pk2(v[u][j].x, v[u][j].y); w.y = pk2(v[u][j].z, v[u][j].w); o8[64 * j] = w; }
            if (lane < 16) part[(size_t)(m + u) * 16 + lane] = lane == 0 ? s : 0.f;
        }
    }
}
__device__ __forceinline__ void final_norm_rows(const bf16_t* src, const float* g, float* dst, int gw, int ngw, int lane) {
    f32x4 gv[4];
#pragma unroll
    for (int j = 0; j < 4; ++j) gv[j] = *((const f32x4*)g + lane + 64 * j);
    for (int m = 4 * gw; m < MTOK; m += 4 * ngw) {
        u32x2 w[4][4];
#pragma unroll
        for (int u = 0; u < 4; ++u)
#pragma unroll
            for (int j = 0; j < 4; ++j) w[u][j] = *((const u32x2*)(src + (size_t)(m + u) * DM) + lane + 64 * j);
#pragma unroll
        for (int u = 0; u < 4; ++u) {
            f32x4 v[4]; float s = 0.f;
#pragma unroll
            for (int j = 0; j < 4; ++j) { v[j] = (f32x4){bflo(w[u][j].x), bfhi(w[u][j].x), bflo(w[u][j].y), bfhi(w[u][j].y)}; s += (v[j].x * v[j].x + v[j].y * v[j].y) + (v[j].z * v[j].z + v[j].w * v[j].w); }
            const float rs = rsqrtf(wave_sum(s) * (1.f / DM) + EPS);
            f32x4* o = (f32x4*)(dst + (size_t)(m + u) * DM) + lane;
#pragma unroll
            for (int j = 0; j < 4; ++j) o[64 * j] = v[j] * rs * gv[j];
        }
    }
}
__device__ __forceinline__ void norm_rows_f32_inplace(float* buf, const float* g, int gw, int ngw, int lane) {
    f32x4 gv[4];
#pragma unroll
    for (int j = 0; j < 4; ++j) gv[j] = *((const f32x4*)g + lane + 64 * j);
    for (int m = gw; m < MTOK; m += ngw) {
        f32x4* xr = (f32x4*)(buf + (size_t)m * DM) + lane;
        f32x4 v[4]; float s = 0.f;
#pragma unroll
        for (int j = 0; j < 4; ++j) { v[j] = xr[64 * j]; s += (v[j].x * v[j].x + v[j].y * v[j].y) + (v[j].z * v[j].z + v[j].w * v[j].w); }
        const float rs = rsqrtf(wave_sum(s) * (1.f / DM) + EPS);
#pragma unroll
        for (int j = 0; j < 4; ++j) xr[64 * j] = v[j] * rs * gv[j];
    }
}

__device__ __forceinline__ void prep_phase(const P& p, LAS unsigned char* lds, int wave, int lane) {
    LAS float* scr = (LAS float*)(lds + wave * 16384);
    const int gw = lbid() * NWAVES + wave, ngw = gridDim.x * NWAVES;
    unsigned char* ws = p.ws;
    constexpr int IT_WIN = 16 * 64, IT_WOUT = 16 * 32, IT_WQKV = 16 * 48, IT_WO = 16 * 32, IT_UP = 16 * 128, IT_DN = 64 * 32, IT_G = 32 * 8;
    constexpr int NIT = IT_WIN + IT_G;
    (void)IT_WOUT; (void)IT_WQKV; (void)IT_WO; (void)IT_UP; (void)IT_DN;
    for (int it = gw; it < NIT; it += ngw) {
        int r = it;
        if (r < IT_WIN) { transpose_item(p.in[I_WIN], DM, 2 * DM, (bf16_t*)(ws + WS_WIN), 0, scr, r, lane, p.in[I_GMIX]); continue; } r -= IT_WIN;
        {
            const int mi = r >> 3, sub = r & 7, ax = mi >> 4, d = (mi >> 3) & 1, h = mi & 7;
            const float* W = (ax ? p.in[I_WX] : p.in[I_WA]) + (size_t)(d * 8 + h) * 128 * 128;
            transpose_item(W, 128, 128, (bf16_t*)(ws + WS_WG) + (size_t)h * 512 * 128, (d * 2 + ax) * 128, scr, sub, lane);
        }
    }
    xb_rows(p.in[I_X], (bf16_t*)(ws + WS_HN), (float*)(ws + WS_PART), gw, ngw, lane);
}

constexpr int TL = 64, NCHK = SEQ / TL;
constexpr int A_PITCH = 272, H_PITCH = 132;
constexpr int L_A = 0, L_H = 17408, L_CW = L_H + 33792, L_RAW = L_CW + 2560;
static_assert(L_RAW + 68 * 256 <= LDS_MAIN, "lds");

template <bool REV>
__device__ __forceinline__ void lru_scan(f32x4 (&av)[4], f32x4 (&uv)[4], float& S, int fr, int fq) {
    const int fqe = REV ? 3 - fq : fq;
    const bool g1 = fqe >= 1, g2 = fqe >= 2, g3 = fqe >= 3;
    float Ak[4][4], Hk[4][4];
#pragma unroll
    for (int mi = 0; mi < 4; ++mi) {
        const int m = REV ? 3 - mi : mi;
        const f32x4 a = av[m], u = uv[m];
        float Hl, Al;
        if (!REV) { Hl = u[0]; Al = a[0]; Hl = a[1] * Hl + u[1]; Al *= a[1]; Hl = a[2] * Hl + u[2]; Al *= a[2]; Hl = a[3] * Hl + u[3]; Al *= a[3]; }
        else      { Hl = u[3]; Al = a[3]; Hl = a[2] * Hl + u[2]; Al *= a[2]; Hl = a[1] * Hl + u[1]; Al *= a[1]; Hl = a[0] * Hl + u[0]; Al *= a[0]; }
#pragma unroll
        for (int k = 0; k < 4; ++k) { const int src = fr + 16 * (REV ? 3 - k : k); Ak[mi][k] = __shfl(Al, src); Hk[mi][k] = __shfl(Hl, src); }
    }
#pragma unroll
    for (int mi = 0; mi < 4; ++mi) {
        const int m = REV ? 3 - mi : mi;
        const f32x4 a = av[m]; f32x4 u = uv[m];
        const float S0 = S, S1 = Ak[mi][0] * S0 + Hk[mi][0], S2 = Ak[mi][1] * S1 + Hk[mi][1], S3 = Ak[mi][2] * S2 + Hk[mi][2];
        S = Ak[mi][3] * S3 + Hk[mi][3];
        float prev = S0; prev = g1 ? S1 : prev; prev = g2 ? S2 : prev; prev = g3 ? S3 : prev;
        if (!REV) {
#pragma unroll
            for (int j = 0; j < 4; ++j) { prev = a[j] * prev + u[j]; u[j] = prev; }
        } else {
#pragma unroll
            for (int j = 3; j >= 0; --j) { prev = a[j] * prev + u[j]; u[j] = prev; }
        }
        uv[m] = u;
    }
}

#define XB_TMO      128
#define XB_XCNT(j)  (256  + 64 * (j))
#define XB_XSUB(j)  (1280 + 64 * (j))
#define XB_XGEN(j)  (2304 + 64 * (j))
#define XB_TOP      3328
#define XB_TOPGEN   3392
#define XCD_BAR_WORDS 3456
#define XB_SPIN_CAP (1u << 20)
__device__ __forceinline__ unsigned xb_ld(unsigned* p)              { return __hip_atomic_load(p, __ATOMIC_RELAXED, __HIP_MEMORY_SCOPE_AGENT); }
__device__ __forceinline__ unsigned xb_add(unsigned* p, unsigned v) { return __hip_atomic_fetch_add(p, v, __ATOMIC_RELAXED, __HIP_MEMORY_SCOPE_AGENT); }
__device__ __forceinline__ unsigned xb_xcc_id() { return (unsigned)__builtin_amdgcn_s_getreg((3 << 11) | 20) & 0xFu; }
#define XB_SPIN(cond, bar) do { unsigned _sp = 0; while (cond) { __builtin_amdgcn_s_sleep(1); \
    if ((++_sp & 255u) == 0u) { if (xb_ld(&(bar)[XB_TMO])) break; if (_sp > XB_SPIN_CAP) { atomicAdd(&(bar)[XB_TMO], 1u); break; } } } } while (0)
struct XcdBarrier { unsigned* bar; unsigned x; volatile LAS unsigned* st; };
__device__ __forceinline__ XcdBarrier xcd_barrier_post(unsigned* bar, volatile LAS unsigned* st) {
    XcdBarrier b; b.bar = bar; b.x = xb_xcc_id(); b.st = st;
    if (threadIdx.x == 0) (void)xb_add(&bar[XB_XCNT(b.x)], 1u);
    return b;
}
__device__ __forceinline__ void xcd_barrier_complete(unsigned* bar, unsigned x, unsigned& nloc, unsigned& nx) {
    const unsigned G = gridDim.x * gridDim.y * gridDim.z;
    unsigned sum, cnt, mine, sp = 0u;
    for (;;) {
        sum = 0u; cnt = 0u; mine = 0u;
#pragma nounroll
        for (unsigned j = 0; j < 16; ++j) { const unsigned c = xb_ld(&bar[XB_XCNT(j)]); sum += c; cnt += (c > 0u) ? 1u : 0u; mine = (j == x) ? c : mine; }
        if (sum == G) break;
        __builtin_amdgcn_s_sleep(1);
        if ((++sp & 255u) == 0u) { if (xb_ld(&bar[XB_TMO])) break; if (sp > XB_SPIN_CAP) { atomicAdd(&bar[XB_TMO], 1u); break; } }
    }
    nloc = mine > 0u ? mine : 1u; nx = cnt > 0u ? cnt : 1u;
}
__device__ __forceinline__ void xcd_barrier(const XcdBarrier& b, int wv) {
    asm volatile("s_waitcnt vmcnt(0)" ::: "memory");
    __syncthreads();
    unsigned* bar = b.bar; const unsigned bx = b.x;
    if (wv == 0 && __builtin_amdgcn_mbcnt_hi(~0u, __builtin_amdgcn_mbcnt_lo(~0u, 0u)) == 0u) {
        __builtin_amdgcn_s_waitcnt(0);
        unsigned nloc = b.st[0], nx = b.st[1];
        if (nloc == 0u) { xcd_barrier_complete(bar, bx, nloc, nx); b.st[0] = nloc; b.st[1] = nx; }
        const unsigned old = xb_add(&bar[XB_XSUB(bx)], 1u);
        const unsigned gen = old / nloc;
        if (old + 1u == (gen + 1u) * nloc) {
            __builtin_amdgcn_fence(__ATOMIC_RELEASE, "agent");
            asm volatile("s_waitcnt vmcnt(0)" ::: "memory");
            const unsigned og = xb_add(&bar[XB_TOP], 1u);
            const unsigned tg = og / nx;
            if (og + 1u == (tg + 1u) * nx) xb_add(&bar[XB_TOPGEN], 1u);
            else XB_SPIN(xb_ld(&bar[XB_TOPGEN]) == tg, bar);
            __builtin_amdgcn_fence(__ATOMIC_ACQUIRE, "agent");
            xb_add(&bar[XB_XGEN(bx)], 1u);
            asm volatile("s_waitcnt vmcnt(0)" ::: "memory");
        } else {
            XB_SPIN(xb_ld(&bar[XB_XGEN(bx)]) == gen, bar);
            __builtin_amdgcn_fence(__ATOMIC_ACQUIRE, "agent");
            asm volatile("s_waitcnt vmcnt(0)" ::: "memory");
        }
    }
    __syncthreads();
}

constexpr int WC_OUT = 0, WC_QKV = WC_OUT + (DM / 16) * (DM / 32), WC_O = WC_QKV + (DM / 16) * (NQKV / 32), WC_UP0 = WC_O + (DM / 16) * (DM / 32), WC_UP1 = WC_UP0 + (DM / 16) * (DFF / 32),
              WC_DN0 = WC_UP1 + (DM / 16) * (DFF / 32), WC_DN1 = WC_DN0 + (DFF / 16) * (DM / 32), WC_END = WC_DN1 + (DFF / 16) * (DM / 32);
struct WcItem { const float* src; bf16_t* dst; const float* gk; int N; };
template <int K, int N> __device__ __forceinline__ WcItem wconv_mk(const float* W, bf16_t* WT, const float* gk, int r, int lane) {
    constexpr int nblk = N / 32; const int k0 = (r / nblk) * 16 + (lane >> 5) * 8, n = (r % nblk) * 32 + (lane & 31);
    return WcItem{W + (size_t)k0 * N + n, WT + (size_t)n * K + k0, gk ? gk + k0 : nullptr, N};
}
__device__ __forceinline__ WcItem wconv_decode(const P& p, int idx, int lane) {
    unsigned char* ws = p.ws;
    if (idx < WC_QKV) return wconv_mk<DM, DM>(p.in[I_WOUT], (bf16_t*)(ws + WS_WOUT), nullptr, idx - WC_OUT, lane);
    if (idx < WC_O)   return wconv_mk<DM, NQKV>(p.in[I_WQKV], (bf16_t*)(ws + WS_WQKV), p.in[I_GMIX] + DM, idx - WC_QKV, lane);
    if (idx < WC_UP0) return wconv_mk<DM, DM>(p.in[I_WO], (bf16_t*)(ws + WS_WO), nullptr, idx - WC_O, lane);
    if (idx < WC_UP1) return wconv_mk<DM, DFF>(p.in[I_WUP], (bf16_t*)(ws + WS_WUP0), p.in[I_GMLP], idx - WC_UP0, lane);
    if (idx < WC_DN0) return wconv_mk<DM, DFF>(p.in[I_WUP] + (size_t)DM * DFF, (bf16_t*)(ws + WS_WUP1), p.in[I_GMLP] + DM, idx - WC_UP1, lane);
    if (idx < WC_DN1) return wconv_mk<DFF, DM>(p.in[I_WDN], (bf16_t*)(ws + WS_WDN0), nullptr, idx - WC_DN0, lane);
    return wconv_mk<DFF, DM>(p.in[I_WDN] + (size_t)DM * DFF, (bf16_t*)(ws + WS_WDN1), nullptr, idx - WC_DN1, lane);
}
__device__ __forceinline__ void wconv_load(const WcItem& t, float (&v)[8]) {
#pragma unroll
    for (int e = 0; e < 8; ++e) v[e] = t.src[(size_t)e * t.N];
}
__device__ __forceinline__ void wconv_store(const WcItem& t, const float (&v)[8]) {
    f32x4 g0 = (f32x4){1.f, 1.f, 1.f, 1.f}, g1 = g0; if (t.gk) { g0 = *(const f32x4*)(t.gk); g1 = *(const f32x4*)(t.gk + 4); }
    u32x4 o; o.x = pk2(v[0] * g0[0], v[1] * g0[1]); o.y = pk2(v[2] * g0[2], v[3] * g0[3]); o.z = pk2(v[4] * g1[0], v[5] * g1[1]); o.w = pk2(v[6] * g1[2], v[7] * g1[3]);
    *(u32x4*)t.dst = o;
}
__device__ __forceinline__ void lru_mid_barrier(unsigned char* ws, LAS unsigned char* lds, int wv) {
    unsigned char* w = ws; asm volatile("" : "+s"(w));
    XcdBarrier xb; xb.bar = (unsigned*)(w + WS_BAR); xb.x = xb_xcc_id(); xb.st = (volatile LAS unsigned*)(lds + LDS_MAIN);
    xcd_barrier(xb, wv);
}
__device__ __forceinline__ void lru_phase(const P& p, LAS unsigned char* lds, int wv) {
    const int tid = ltid(wv), wid = __builtin_amdgcn_readfirstlane(tid >> 6), lane = tid & 63, fr = lane & 15, fq = lane >> 4;
    const bf16_t* RECPRE = (const bf16_t*)(p.ws + WS_RECPRE);
    const bf16_t* WG = (const bf16_t*)(p.ws + WS_WG);
    const int cv = tid & 15, tp = tid >> 4, lt0 = 2 * tp;
    LAS float* cw = (LAS float*)(lds + L_CW);
    LAS float* hbuf = (LAS float*)(lds + L_H);
    const bf16_t* GATE = (const bf16_t*)(p.ws + WS_GATE);
    bf16_t* Y = (bf16_t*)(p.ws + WS_Y);
    const int G = gridDim.x, ngi = (256 + G - 1) / G;
    const int ngw = G * NWAVES; int widx = lbid() * NWAVES + wid;
    for (int gi = 0; gi < ngi; ++gi) {
        const int grp = lbid() + gi * G;
        if (grp >= 256) { lru_mid_barrier(p.ws, lds, wv); continue; }
        const int d = grp & 1, h = (grp >> 1) & 7, b = grp >> 4;
        bf16_t* HD = (bf16_t*)(p.ws + (d ? WS_HB : WS_HF));
        const bf16_t* HP = (const bf16_t*)(p.ws + (d ? WS_HF : WS_HB));
        bf16x8 bfr[2][4];
#pragma unroll
        for (int nn = 0; nn < 2; ++nn)
#pragma unroll
            for (int kk = 0; kk < 4; ++kk) { const int row = (d * 2 + nn) * 128 + wid * 16 + fr;
                bfr[nn][kk] = *(const bf16x8*)(WG + ((size_t)h * 512 + row) * 128 + kk * 32 + fq * 8); }
        const int chl = wid * 16 + fr, chg = d * DM + h * 128 + chl;
        const float nba = -1.4426950408889634f * p.in[I_BA][chg], nbx = -1.4426950408889634f * p.in[I_BX][chg], clu = -8.0f * log1pf(expf(-p.in[I_LAM][chg]));
        __syncthreads();
        for (int i = tid; i < 640; i += NTHREADS) { const int tap = i >> 7, ch = i & 127; cw[i] = tap < 4 ? p.in[I_CONVW][tap * DM + h * 128 + ch] : p.in[I_CONVB][h * 128 + ch]; }
#define LRU_DMA_ROWS(c) do { _Pragma("unroll") for (int qi = 0; qi < 3; ++qi) { const int qq = wid + 8 * qi; if (qq < 17) { \
            int t = (c) * TL + 4 * qq + (lane >> 4) - 2; t = t < 0 ? 0 : (t > SEQ - 1 ? SEQ - 1 : t); \
            __builtin_amdgcn_global_load_lds((const unsigned*)(RECPRE + ((size_t)(b * SEQ + t)) * DM + h * 128 + (lane & 15) * 8), (LAS unsigned*)(lds + L_RAW + qq * 1024), 16, 0, 0); } } } while (0)
        LRU_DMA_ROWS(d ? NCHK - 1 : 0);
        asm volatile("s_waitcnt vmcnt(0)" ::: "memory");
        __syncthreads();
        float S = 0.f;
        for (int ci = 0; ci < NCHK; ++ci) {
            const int c = d ? NCHK - 1 - ci : ci;
            if (ci == NCHK / 2) lru_mid_barrier(p.ws, lds, wv);
            const bool comb = ci >= NCHK / 2;
            float wcv[8]; const bool wc_on = widx < WC_END; WcItem wt{};
            if (wc_on) { wt = wconv_decode(p, widx, lane); wconv_load(wt, wcv); }
            u32x4 ph[2], gt[2];
            if (comb) {
#pragma unroll
                for (int tt = 0; tt < 2; ++tt) { const size_t o = ((size_t)(b * SEQ + c * TL + lt0 + tt)) * DM + h * 128 + cv * 8; ph[tt] = *(const u32x4*)(HP + o); gt[tt] = *(const u32x4*)(GATE + o); }
            }
            {
                u32x4 rw[5];
#pragma unroll
                for (int i = 0; i < 5; ++i) { const int t = c * TL + lt0 - 2 + i; const u32x4 v = *(const LAS u32x4*)(lds + L_RAW + (lt0 + i) * 256 + cv * 16);
                    rw[i] = (t >= 0 && t < SEQ) ? v : (u32x4){0u, 0u, 0u, 0u}; }
                f32x4 wv[5][2];
#pragma unroll
                for (int tap = 0; tap < 5; ++tap) { wv[tap][0] = *(const LAS f32x4*)(cw + tap * 128 + cv * 8); wv[tap][1] = *(const LAS f32x4*)(cw + tap * 128 + cv * 8 + 4); }
                u32x4 o0, o1;
#pragma unroll
                for (int e = 0; e < 4; ++e) {
                    f32x2 W[5], X[5];
#pragma unroll
                    for (int tap = 0; tap < 5; ++tap) W[tap] = (f32x2){wv[tap][e >> 1][(2 * e) & 3], wv[tap][e >> 1][(2 * e + 1) & 3]};
#pragma unroll
                    for (int i = 0; i < 5; ++i) X[i] = (f32x2){bflo(rw[i][e]), bfhi(rw[i][e])};
                    f32x2 a0 = W[4], a1 = W[4];
                    a0 = W[0] * X[0] + a0; a0 = W[1] * X[1] + a0; a0 = W[2] * X[2] + a0; a0 = W[3] * X[3] + a0;
                    a1 = W[0] * X[1] + a1; a1 = W[1] * X[2] + a1; a1 = W[2] * X[3] + a1; a1 = W[3] * X[4] + a1;
                    o0[e] = pk2(a0.x, a0.y); o1[e] = pk2(a1.x, a1.y);
                }
                *(LAS u32x4*)(lds + L_A + lt0 * A_PITCH + cv * 16) = o0;
                *(LAS u32x4*)(lds + L_A + (lt0 + 1) * A_PITCH + cv * 16) = o1;
            }
            __syncthreads();
            if (ci + 1 < NCHK) LRU_DMA_ROWS(d ? c - 1 : c + 1);
            f32x4 av[4], uv[4];
#pragma unroll
            for (int m = 0; m < 4; ++m) { av[m] = (f32x4){0.f, 0.f, 0.f, 0.f}; uv[m] = (f32x4){0.f, 0.f, 0.f, 0.f}; }
#pragma unroll
            for (int m = 0; m < 4; ++m)
#pragma unroll
                for (int kk = 0; kk < 4; ++kk) {
                    const bf16x8 a = *(const LAS bf16x8*)(lds + L_A + (m * 16 + fr) * A_PITCH + (kk * 32 + fq * 8) * 2);
                    av[m] = __builtin_amdgcn_mfma_f32_16x16x32_bf16(a, bfr[0][kk], av[m], 0, 0, 0);
                    uv[m] = __builtin_amdgcn_mfma_f32_16x16x32_bf16(a, bfr[1][kk], uv[m], 0, 0, 0);
                }
#pragma unroll
            for (int m = 0; m < 4; ++m)
#pragma unroll
                for (int jp = 0; jp < 4; jp += 2) {
                    const int tok = m * 16 + fq * 4 + jp;
                    f32x2 x;
                    x.x = __uint_as_float((unsigned)(*(const LAS unsigned short*)(lds + L_A + tok * A_PITCH + chl * 2)) << 16);
                    x.y = __uint_as_float((unsigned)(*(const LAS unsigned short*)(lds + L_A + (tok + 1) * A_PITCH + chl * 2)) << 16);
                    const f32x2 zr = {av[m][jp], av[m][jp + 1]}, zi = {uv[m][jp], uv[m][jp + 1]};
                    f32x2 ar = zr * (-1.4426950408889634f) + nba, ai_ = zi * (-1.4426950408889634f) + nbx;
                    ar = __builtin_elementwise_min(ar, (f32x2){80.f, 80.f}); ai_ = __builtin_elementwise_min(ai_, (f32x2){80.f, 80.f});
                    f32x2 e1, e2; e1.x = __builtin_amdgcn_exp2f(ar.x); e1.y = __builtin_amdgcn_exp2f(ar.y); e2.x = __builtin_amdgcn_exp2f(ai_.x); e2.y = __builtin_amdgcn_exp2f(ai_.y);
                    const f32x2 d1 = e1 + 1.f, d2 = e2 + 1.f, pr = d1 * d2;
                    f32x2 R; R.x = __builtin_amdgcn_rcpf(pr.x); R.y = __builtin_amdgcn_rcpf(pr.y);
                    const f32x2 r = R * d2, ig = R * d1;
                    const f32x2 la = r * clu;
                    f32x2 pq = la * 0.0001984127f + 0.0013888889f; pq = pq * la + 0.0083333338f; pq = pq * la + 0.041666668f; pq = pq * la + 0.16666667f; pq = pq * la + 0.5f; pq = pq * la + 1.f;
                    const f32x2 q = -(la * pq);
                    const f32x2 s2 = q * (2.f - q);
                    f32x2 mult; mult.x = __builtin_amdgcn_sqrtf(fmaxf(s2.x, 0.f)); mult.y = __builtin_amdgcn_sqrtf(fmaxf(s2.y, 0.f));
                    const f32x2 an = 1.f - q, un = mult * (ig * x);
                    av[m][jp] = an.x; av[m][jp + 1] = an.y; uv[m][jp] = un.x; uv[m][jp + 1] = un.y;
                }
            if (d == 0) lru_scan<false>(av, uv, S, fr, fq); else lru_scan<true>(av, uv, S, fr, fq);
#pragma unroll
            for (int m = 0; m < 4; ++m)
#pragma unroll
                for (int j = 0; j < 4; ++j) hbuf[(m * 16 + fq * 4 + j) * H_PITCH + chl] = uv[m][j];
            asm volatile("s_waitcnt vmcnt(0)" ::: "memory");
            __syncthreads();
#pragma unroll
            for (int tt = 0; tt < 2; ++tt) {
                const LAS float* hp = hbuf + (lt0 + tt) * H_PITCH + cv * 8;
                const f32x4 f0 = *(const LAS f32x4*)hp, f1 = *(const LAS f32x4*)(hp + 4);
                u32x4 w; const size_t o = ((size_t)(b * SEQ + c * TL + lt0 + tt)) * DM + h * 128 + cv * 8;
                if (!comb) { w.x = pk2(f0[0], f0[1]); w.y = pk2(f0[2], f0[3]); w.z = pk2(f1[0], f1[1]); w.w = pk2(f1[2], f1[3]); *(u32x4*)(HD + o) = w; }
                else {
                    const u32x4 q = ph[tt], g = gt[tt];
                    w.x = pk2((f0[0] + bflo(q.x)) * bflo(g.x), (f0[1] + bfhi(q.x)) * bfhi(g.x)); w.y = pk2((f0[2] + bflo(q.y)) * bflo(g.y), (f0[3] + bfhi(q.y)) * bfhi(g.y));
                    w.z = pk2((f1[0] + bflo(q.z)) * bflo(g.z), (f1[1] + bfhi(q.z)) * bfhi(g.z)); w.w = pk2((f1[2] + bflo(q.w)) * bflo(g.w), (f1[3] + bfhi(q.w)) * bfhi(g.w));
                    *(u32x4*)(Y + o) = w; }
            }
            if (wc_on) { wconv_store(wt, wcv); widx += ngw;
            }
        }
#undef LRU_DMA_ROWS
    }
    for (; widx < WC_END; widx += ngw) { const WcItem wt2 = wconv_decode(p, widx, lane); float v[8]; wconv_load(wt2, v); wconv_store(wt2, v); }
}
__device__ __forceinline__ void ycomb_phase(const P& p, int wv) {
    const u32x4* HF = (const u32x4*)(p.ws + WS_HF); const u32x4* HB = (const u32x4*)(p.ws + WS_HB); const u32x4* GT = (const u32x4*)(p.ws + WS_GATE);
    u32x4* Y = (u32x4*)(p.ws + WS_Y);
    const size_t n = (size_t)MTOK * DM / 8, stride = (size_t)gridDim.x * NTHREADS;
    for (size_t i = (size_t)lbid() * NTHREADS + ltid(wv); i < n; i += 4 * stride) {
        u32x4 f[4], k[4], g[4];
#pragma unroll
        for (int u = 0; u < 4; ++u) { const size_t ii = i + u * stride; if (ii < n) { f[u] = HF[ii]; k[u] = HB[ii]; g[u] = GT[ii]; } }
#pragma unroll
        for (int u = 0; u < 4; ++u) { const size_t ii = i + u * stride; if (ii < n) { u32x4 w;
#pragma unroll
            for (int e = 0; e < 4; ++e) w[e] = pk2((bflo(f[u][e]) + bflo(k[u][e])) * bflo(g[u][e]), (bfhi(f[u][e]) + bfhi(k[u][e])) * bfhi(g[u][e]));
            Y[ii] = w; } }
    }
}

__device__ __forceinline__ u32x4 rope_chunk(u32x4 w, const float (&g)[8], const float (&cs)[8], const float (&sn)[8]) {
    float v[8] = {bflo(w.x), bfhi(w.x), bflo(w.y), bfhi(w.y), bflo(w.z), bfhi(w.z), bflo(w.w), bfhi(w.w)};
    float ss = 0.f;
#pragma unroll
    for (int e = 0; e < 8; ++e) ss += v[e] * v[e];
    ss += lane_xor<1>(ss); ss += lane_xor<2>(ss); ss += lane_xor<4>(ss); ss += lane_xor<8>(ss);
    const float rs = rsqrtf(ss * (1.f / 128.f) + EPS);
    float o[8];
#pragma unroll
    for (int e = 0; e < 8; ++e) { const float y = v[e] * rs * g[e]; const float py = lane_xor<4>(y); o[e] = y * cs[e] + py * sn[e]; }
    u32x4 r; r.x = pk2(o[0], o[1]); r.y = pk2(o[2], o[3]); r.z = pk2(o[4], o[5]); r.w = pk2(o[6], o[7]);
    return r;
}
__device__ __forceinline__ void rope_phase(const P& p, int wave, int lane, bool dry) {
    bf16_t* Q = (bf16_t*)(p.ws + WS_Q); bf16_t* Kb = (bf16_t*)(p.ws + WS_K);
    bf16_t* Qo = dry ? (bf16_t*)(p.ws + WS_HB) : Q; bf16_t* Ko = dry ? (bf16_t*)(p.ws + WS_HB) : Kb;
    const int gw = lbid() * NWAVES + wave, ngw = gridDim.x * NWAVES;
    const int j = lane & 15, hs = lane >> 4;
    float gq[8], gk[8], inv[8];
#pragma unroll
    for (int e = 0; e < 8; ++e) { gq[e] = p.in[I_QG][8 * j + e]; gk[e] = p.in[I_KG][8 * j + e]; inv[e] = exp2f(-(float)(8 * (j & 3) + e) * (13.287712379549449f / 32.f)) * 0.15915494309189535f; }
    const float sgn = (j & 4) ? 1.f : -1.f;
    for (int tk = 2 * gw; tk < MTOK; tk += 2 * ngw) {
        u32x4 qa[2], qb[2], kk[2];
#pragma unroll
        for (int u = 0; u < 2; ++u) { const size_t tok = tk + u;
            qa[u] = *(const u32x4*)(Q + tok * DM + hs * 128 + j * 8); qb[u] = *(const u32x4*)(Q + tok * DM + 512 + hs * 128 + j * 8);
            kk[u] = *(const u32x4*)(Kb + tok * NKV + (hs & 1) * 128 + j * 8); }
#pragma unroll
        for (int u = 0; u < 2; ++u) { const size_t tok = tk + u; const int t = (int)tok & (SEQ - 1);
            const float pos = (float)(j < 8 ? (t >> 6) : (t & 63));
            float cs[8], sn[8];
#pragma unroll
            for (int e = 0; e < 8; ++e) { const float a = pos * inv[e]; cs[e] = __builtin_amdgcn_cosf(a); sn[e] = sgn * __builtin_amdgcn_sinf(a); }
            const u32x4 ra = rope_chunk(qa[u], gq, cs, sn), rb = rope_chunk(qb[u], gq, cs, sn), rk = rope_chunk(kk[u], gk, cs, sn);
            *(u32x4*)(Qo + tok * DM + hs * 128 + j * 8) = ra; *(u32x4*)(Qo + tok * DM + 512 + hs * 128 + j * 8) = rb;
            if (hs < 2) *(u32x4*)(Ko + tok * NKV + hs * 128 + j * 8) = rk; }
    }
}

__device__ __forceinline__ void rope_tile(bf16_t* base, int ld, int tok0, const float* g, int wave, int lane) {
    const int j = lane & 15, hs = lane >> 4, rr = hs >> 1, hh = hs & 1;
    float g8[8], inv[8];
#pragma unroll
    for (int e = 0; e < 8; ++e) { g8[e] = g[8 * j + e]; inv[e] = exp2f(-(float)(8 * (j & 3) + e) * (13.287712379549449f / 32.f)) * 0.15915494309189535f; }
    const float sgn = (j & 4) ? 1.f : -1.f;
    for (int it = 0; it < 16; it += 8) {
        u32x4 w[8];
#pragma unroll
        for (int u = 0; u < 8; ++u) { const int r = wave * 32 + (it + u) * 2 + rr; w[u] = *(const u32x4*)(base + (size_t)r * ld + hh * 128 + j * 8); }
#pragma unroll
        for (int u = 0; u < 8; ++u) { const int r = wave * 32 + (it + u) * 2 + rr; const int t = (tok0 + r) & (SEQ - 1);
            const float pos = (float)(j < 8 ? (t >> 6) : (t & 63));
            float cs[8], sn[8];
#pragma unroll
            for (int e = 0; e < 8; ++e) { const float a = pos * inv[e]; cs[e] = __builtin_amdgcn_cosf(a); sn[e] = sgn * __builtin_amdgcn_sinf(a); }
            *(u32x4*)(base + (size_t)r * ld + hh * 128 + j * 8) = rope_chunk(w[u], g8, cs, sn); }
    }
}

namespace attn {
constexpr int D = 128, NW = 8, QBLK = 32, KVBLK = 64;
constexpr float SCALE = 0.088388347648318440f;
constexpr float THR = 8.f;
constexpr int LDQ = DM, LDK = NKV, LDO = DM;
constexpr size_t SHM_V = KVBLK * D * 2, SHM_K = KVBLK * D * 2, SHM_ATTN = 2 * SHM_V + 2 * SHM_K + NW * 64 * 4;
#define KSWZ(row, colB) ((row) * 256 + ((colB) ^ (((row) & 7) << 4)))
#define SBAR() __builtin_amdgcn_sched_barrier(0)
__device__ __forceinline__ int crow(int r, int hi) { return (r & 3) + 8 * (r >> 2) + 4 * hi; }
__device__ __forceinline__ unsigned cvtpk(float lo, float hi) { unsigned r; asm volatile("v_cvt_pk_bf16_f32 %0, %1, %2" : "=v"(r) : "v"(lo), "v"(hi)); return r; }
__device__ __forceinline__ void partialSM(f32x16& p0, f32x16& p1, float& m_reg, float& mn, float& alpha) {
    constexpr float C = SCALE * 1.4426950408889634f;
    float pmax = p0[0]; for (int r = 1; r < 16; ++r) pmax = fmaxf(pmax, p0[r]); for (int r = 0; r < 16; ++r) pmax = fmaxf(pmax, p1[r]);
    { auto rr = __builtin_amdgcn_permlane32_swap(__float_as_uint(pmax), __float_as_uint(pmax), false, false);
      pmax = fmaxf(__uint_as_float(rr[0]), __uint_as_float(rr[1])); }
    if (__builtin_expect(__all(pmax - m_reg <= THR / SCALE), 1)) { mn = m_reg; alpha = 1.f; }
    else { mn = fmaxf(m_reg, pmax); alpha = __builtin_amdgcn_exp2f((m_reg - mn) * C); m_reg = mn; }
    float mnC = -mn * C;
    for (int r = 0; r < 16; ++r) p0[r] = fmaf(p0[r], C, mnC); for (int r = 0; r < 16; ++r) p1[r] = fmaf(p1[r], C, mnC);
    for (int r = 0; r < 16; ++r) p0[r] = __builtin_amdgcn_exp2f(p0[r]);
}
__device__ __forceinline__ void finishSM(f32x16& p0, f32x16& p1, float alpha, float& l_reg, bf16x8& pa0, bf16x8& pa1, bf16x8& pa2, bf16x8& pa3) {
    for (int r = 0; r < 16; ++r) p1[r] = __builtin_amdgcn_exp2f(p1[r]);
    float ps = 0; for (int r = 0; r < 16; ++r) ps += p0[r]; for (int r = 0; r < 16; ++r) ps += p1[r];
    { auto rr = __builtin_amdgcn_permlane32_swap(__float_as_uint(ps), __float_as_uint(ps), false, false);
      ps = __uint_as_float(rr[0]) + __uint_as_float(rr[1]); }
    l_reg = l_reg * alpha + ps;
#define PK4(P, BASE, OUT) do { unsigned a0 = cvtpk(P[BASE + 0], P[BASE + 1]), a1 = cvtpk(P[BASE + 2], P[BASE + 3]);   \
    unsigned b0 = cvtpk(P[BASE + 4], P[BASE + 5]), b1 = cvtpk(P[BASE + 6], P[BASE + 7]);                              \
    auto r0 = __builtin_amdgcn_permlane32_swap(a0, b0, false, false); auto r1 = __builtin_amdgcn_permlane32_swap(a1, b1, false, false); \
    u32x4 w = {r0[0], r1[0], r0[1], r1[1]}; OUT = *reinterpret_cast<bf16x8*>(&w); } while (0)
    PK4(p0, 0, pa0); PK4(p0, 8, pa1); PK4(p1, 0, pa2); PK4(p1, 8, pa3);
#undef PK4
}
__device__ __forceinline__ void qkt(f32x16& p0, f32x16& p1, const bf16_t* Ks, const bf16x8* qr, int r32, int hi) {
    p0 = f32x16{}; p1 = f32x16{};
    for (int d0 = 0; d0 < 8; ++d0) { int cb = (d0 * 16 + hi * 8) * 2;
        bf16x8 b0 = *reinterpret_cast<const bf16x8*>((const char*)Ks + KSWZ(r32, cb));
        bf16x8 b1 = *reinterpret_cast<const bf16x8*>((const char*)Ks + KSWZ(32 + r32, cb));
        p0 = __builtin_amdgcn_mfma_f32_32x32x16_bf16(b0, qr[d0], p0, 0, 0, 0);
        p1 = __builtin_amdgcn_mfma_f32_32x32x16_bf16(b1, qr[d0], p1, 0, 0, 0); }
}
__device__ __forceinline__ int v_st(int k, int c) { const int kk = (k & ~0xC) | ((k & 4) << 1) | ((k & 8) >> 1); return ((kk >> 3) * 4 + (c >> 5)) * 512 + ((kk & 7) * 32 + (c & 31)) * 2; }
__device__ __forceinline__ int v_rd_base(int lane) { return ((lane & 3) << 3) | (((lane >> 2) & 3) << 6) | (((lane >> 4) & 1) << 5) | (((lane >> 5) & 1) << 8); }
constexpr int v_rd_off(int d0, int ks, int half) { return d0 * 512 + ks * 4096 + half * 2048; }
template <int OFF> __device__ __forceinline__ s16x4 tr_read(int vb) {
    s16x4 r; asm volatile("ds_read_b64_tr_b16 %0, %1 offset:%2" : "=&v"(r) : "v"(vb), "i"(OFF) : "memory"); return r;
}
template <int D0> __device__ __forceinline__ void pv_one(f32x16& od, int vb, bf16x8 pa0, bf16x8 pa1, bf16x8 pa2, bf16x8 pa3) {
    const s16x4 l0 = tr_read<v_rd_off(D0, 0, 0)>(vb), h0 = tr_read<v_rd_off(D0, 0, 1)>(vb), l1 = tr_read<v_rd_off(D0, 1, 0)>(vb), h1 = tr_read<v_rd_off(D0, 1, 1)>(vb);
    const s16x4 l2 = tr_read<v_rd_off(D0, 2, 0)>(vb), h2 = tr_read<v_rd_off(D0, 2, 1)>(vb), l3 = tr_read<v_rd_off(D0, 3, 0)>(vb), h3 = tr_read<v_rd_off(D0, 3, 1)>(vb);
    asm volatile("s_waitcnt lgkmcnt(0)" ::: "memory"); SBAR();
#define PK(L, H) (bf16x8){L[0], L[1], L[2], L[3], H[0], H[1], H[2], H[3]}
    od = __builtin_amdgcn_mfma_f32_32x32x16_bf16(pa0, PK(l0, h0), od, 0, 0, 0);
    od = __builtin_amdgcn_mfma_f32_32x32x16_bf16(pa1, PK(l1, h1), od, 0, 0, 0);
    od = __builtin_amdgcn_mfma_f32_32x32x16_bf16(pa2, PK(l2, h2), od, 0, 0, 0);
    od = __builtin_amdgcn_mfma_f32_32x32x16_bf16(pa3, PK(l3, h3), od, 0, 0, 0);
#undef PK
}
__device__ __forceinline__ void pv_d0(f32x16* o, int vb, bf16x8 pa0, bf16x8 pa1, bf16x8 pa2, bf16x8 pa3) {
    pv_one<0>(o[0], vb, pa0, pa1, pa2, pa3); pv_one<1>(o[1], vb, pa0, pa1, pa2, pa3); pv_one<2>(o[2], vb, pa0, pa1, pa2, pa3); pv_one<3>(o[3], vb, pa0, pa1, pa2, pa3);
}
__device__ __forceinline__ void attn_dense_body(const bf16_t* Qb, const bf16_t* __restrict__ Kh, const bf16_t* __restrict__ Vh,
                                                bf16_t* Ob, int seq, char* lds, int wv, const float* qg, int t0) {
    const int tid = ltid(wv), wid = tid >> 6, lane = tid & 63, r32 = lane & 31, hi = lane >> 5;
    bf16_t* V_lds = (bf16_t*)lds; bf16_t* K_lds = (bf16_t*)(lds + 2 * SHM_V);
    float* ws = (float*)(lds + 2 * SHM_V + 2 * SHM_K) + wid * 64; float* li_l = ws; float* al_l = ws + 32;
    float m_reg = -1e30f, l_reg = 0; f32x16 o[4] = {}; bf16x8 qr[8];
    const bf16_t* Qw = Qb + (long)(wid * QBLK + r32) * LDQ + hi * 8;
#pragma unroll
    for (int d0 = 0; d0 < 8; ++d0) qr[d0] = *reinterpret_cast<const bf16x8*>(Qw + d0 * 16);
    {
        float ss = 0.f;
#pragma unroll
        for (int d0 = 0; d0 < 8; ++d0) { const u32x4 w = *reinterpret_cast<const u32x4*>(&qr[d0]);
#pragma unroll
            for (int e = 0; e < 4; ++e) { const float lo = bflo(w[e]), hi_ = bfhi(w[e]); ss += lo * lo + hi_ * hi_; } }
        ss = sum_xor32(ss);
        const float rs = rsqrtf(ss * (1.f / 128.f) + EPS);
        const int t = t0 + wid * QBLK + r32;
#pragma unroll
        for (int a = 0; a < 2; ++a) {
            const float pos = (float)(a ? (t & 63) : (t >> 6));
#pragma unroll
            for (int j = 0; j < 2; ++j) {
                const int c1 = 4 * a + j, c2 = c1 + 2;
                const u32x4 w1 = *reinterpret_cast<const u32x4*>(&qr[c1]), w2 = *reinterpret_cast<const u32x4*>(&qr[c2]);
                const f32x4 g1a = *(const f32x4*)(qg + c1 * 16 + hi * 8), g1b = *(const f32x4*)(qg + c1 * 16 + hi * 8 + 4), g2a = *(const f32x4*)(qg + c2 * 16 + hi * 8), g2b = *(const f32x4*)(qg + c2 * 16 + hi * 8 + 4);
                float o1[8], o2[8];
#pragma unroll
                for (int e = 0; e < 8; ++e) {
                    const float x1 = (e & 1) ? bfhi(w1[e >> 1]) : bflo(w1[e >> 1]), x2 = (e & 1) ? bfhi(w2[e >> 1]) : bflo(w2[e >> 1]);
                    const float g1 = e < 4 ? g1a[e & 3] : g1b[e & 3], g2 = e < 4 ? g2a[e & 3] : g2b[e & 3];
                    const float ang = pos * (exp2f(-(float)(j * 16 + hi * 8 + e) * (13.287712379549449f / 32.f)) * 0.15915494309189535f);
                    const float cs = __builtin_amdgcn_cosf(ang), sn = __builtin_amdgcn_sinf(ang);
                    const float y1 = x1 * rs * g1, y2 = x2 * rs * g2;
                    o1[e] = y1 * cs - y2 * sn; o2[e] = y2 * cs + y1 * sn;
                }
                u32x4 p1, p2;
#pragma unroll
                for (int e = 0; e < 4; ++e) { p1[e] = cvtpk(o1[2 * e], o1[2 * e + 1]); p2[e] = cvtpk(o2[2 * e], o2[2 * e + 1]); }
                qr[c1] = *reinterpret_cast<const bf16x8*>(&p1); qr[c2] = *reinterpret_cast<const bf16x8*>(&p2);
            }
        }
    }
    const int sr = tid >> 4, sc = (tid & 15) * 8, vst0 = v_st(sr, sc), vst1 = v_st(32 + sr, sc);
    const int vb0 = (int)(uintptr_t)V_lds + v_rd_base(lane);
    struct { bf16x8 vs0, vs1, ks0, ks1; } sr_[2];
#define LD8(p) (*reinterpret_cast<const bf16x8*>(p))
#define SLOAD(i, k0) do { sr_[i].vs0 = LD8(&Vh[(long)((k0) + sr) * LDK + sc]); sr_[i].vs1 = LD8(&Vh[(long)((k0) + 32 + sr) * LDK + sc]); \
    sr_[i].ks0 = LD8(&Kh[(long)((k0) + sr) * LDK + sc]); sr_[i].ks1 = LD8(&Kh[(long)((k0) + 32 + sr) * LDK + sc]); } while (0)
#define SWRITE(b, i) do { *(bf16x8*)((char*)V_lds + (b) * SHM_V + vst0) = sr_[i].vs0;          \
    *(bf16x8*)((char*)V_lds + (b) * SHM_V + vst1) = sr_[i].vs1; int kc = sc * 2;               \
    *(bf16x8*)((char*)K_lds + (b) * SHM_K + KSWZ(sr, kc)) = sr_[i].ks0;                       \
    *(bf16x8*)((char*)K_lds + (b) * SHM_K + KSWZ(32 + sr, kc)) = sr_[i].ks1; } while (0)
#define SWAIT() asm volatile("s_waitcnt vmcnt(4)" ::: "memory")
#define RESC(a) do { if (__any((a) < 1.f)) { if (hi == 0) al_l[r32] = (a); asm volatile("s_waitcnt lgkmcnt(0)" ::: "memory"); \
    for (int d = 0; d < 4; ++d) for (int r = 0; r < 16; ++r) o[d][r] *= al_l[crow(r, hi)]; } } while (0)
    f32x16 pA0, pA1, pB0, pB1; float mnA, mnB, alA, alB; bf16x8 pa0, pa1, pa2, pa3; const int NT = seq / KVBLK;
    constexpr int SE = 0, SO = 1;
    SLOAD(SE, 0); asm volatile("s_waitcnt vmcnt(0)" ::: "memory"); SWRITE(0, SE); __syncthreads();
    qkt(pA0, pA1, K_lds, qr, r32, hi); partialSM(pA0, pA1, m_reg, mnA, alA);
    SLOAD(SO, KVBLK); if (2 < NT) SLOAD(SE, 2 * KVBLK);
    SWAIT(); SWRITE(1, SO); __syncthreads();
    for (int j = 1; j + 1 < NT; j += 2) {
        SBAR(); qkt(pB0, pB1, (bf16_t*)((char*)K_lds + SHM_K), qr, r32, hi);
        finishSM(pA0, pA1, alA, l_reg, pa0, pa1, pa2, pa3); SBAR();
        SLOAD(SO, (j + 2) * KVBLK); SBAR();
        pv_d0(o, vb0, pa0, pa1, pa2, pa3); partialSM(pB0, pB1, m_reg, mnB, alB);
        __syncthreads(); SWAIT(); SWRITE(0, SE);
        RESC(alB); __syncthreads();
        SBAR(); qkt(pA0, pA1, K_lds, qr, r32, hi);
        finishSM(pB0, pB1, alB, l_reg, pa0, pa1, pa2, pa3); SBAR();
        if (j + 3 < NT) SLOAD(SE, (j + 3) * KVBLK); SBAR();
        pv_d0(o, vb0 + (int)SHM_V, pa0, pa1, pa2, pa3); partialSM(pA0, pA1, m_reg, mnA, alA);
        __syncthreads(); SWAIT(); SWRITE(1, SO);
        RESC(alA); __syncthreads();
    }
    SBAR(); qkt(pB0, pB1, (bf16_t*)((char*)K_lds + SHM_K), qr, r32, hi);
    finishSM(pA0, pA1, alA, l_reg, pa0, pa1, pa2, pa3); SBAR();
    pv_d0(o, vb0, pa0, pa1, pa2, pa3); partialSM(pB0, pB1, m_reg, mnB, alB);
    __syncthreads(); RESC(alB);
    finishSM(pB0, pB1, alB, l_reg, pa0, pa1, pa2, pa3); SBAR();
    pv_d0(o, vb0 + (int)SHM_V, pa0, pa1, pa2, pa3);
    if (hi == 0) li_l[r32] = l_reg; asm volatile("s_waitcnt lgkmcnt(0)" ::: "memory");
    float rli[16];
#pragma unroll
    for (int r = 0; r < 16; ++r) rli[r] = __builtin_amdgcn_rcpf(li_l[crow(r, hi)]);
    bf16_t* Ow = Ob + (long)(wid * QBLK) * LDO;
    const int odd = lane & 1;
#pragma unroll
    for (int r = 0; r < 16; r += 2) {
#pragma unroll
        for (int d0 = 0; d0 < 4; ++d0) {
            const float m0 = o[d0][r] * rli[r], m1 = o[d0][r + 1] * rli[r + 1];
            const float snd = odd ? m0 : m1;
            const float rcv = lane_xor<1>(snd);
            const unsigned w = odd ? cvtpk(rcv, m1) : cvtpk(m0, rcv);
            const int orow = crow(odd ? r + 1 : r, hi);
            *(unsigned*)(Ow + (long)orow * LDO + d0 * 32 + (r32 & ~1)) = w;
        }
    }
#undef LD8
#undef SLOAD
#undef SWRITE
#undef SWAIT
#undef RESC
}
}

__device__ __forceinline__ void attn_phase(const P& p, char* lds, bool dry, int wv) {
    const bf16_t* Q = (const bf16_t*)(p.ws + WS_Q); const bf16_t* Kb = (const bf16_t*)(p.ws + WS_K); const bf16_t* Vb = (const bf16_t*)(p.ws + WS_V);
    bf16_t* O = (bf16_t*)(p.ws + (dry ? WS_HB : WS_Q));
    const int G = gridDim.x, bx = lbid();
    const int vcu = (G % 8 == 0) ? (bx % 8) * (G / 8) + bx / 8 : bx;
    for (int it = vcu; it < BATCH * 8 * 8; it += G) {
        const int grp = it >> 5, within = it & 31, b = grp >> 1, kvh = grp & 1, h = kvh * 4 + (within >> 3), qb = within & 7;
        __syncthreads();
        attn::attn_dense_body(Q + ((size_t)(b * SEQ + qb * 256)) * DM + h * 128, Kb + (size_t)b * SEQ * NKV + kvh * 128, Vb + (size_t)b * SEQ * NKV + kvh * 128,
                              O + ((size_t)(b * SEQ + qb * 256)) * DM + h * 128, SEQ, lds, wv, p.in[I_QG], qb * 256);
    }
    __syncthreads();
}

constexpr int NPHASE = 14;
#ifndef ONLY
#define ONLY -1
#endif
#ifndef ENMASK
#define ENMASK 0x3fff
#endif
#ifndef REPMASK
#define REPMASK 0
#endif
#define EN(k) ((ONLY < 0 || ONLY == (k)) && ((ENMASK >> (k)) & 1))
typedef const __attribute__((address_space(4))) P* KP;
__device__ __forceinline__ P load_params() {
#if defined(__HIP_DEVICE_COMPILE__)
    KP kp = (KP)__builtin_amdgcn_kernarg_segment_ptr();
    asm volatile("" : "+s"(kp));
    return *kp;
#else
    return P{};
#endif
}
__global__ void __launch_bounds__(NTHREADS) mega(P parg) {
    extern __shared__ __attribute__((aligned(16))) unsigned char shm[];
    LAS unsigned char* lds = (LAS unsigned char*)shm;
    cg::grid_group grid = cg::this_grid();
    const int ph_lo = parg.ph_lo, ph_hi = parg.ph_hi;
    const int wv0 = __builtin_amdgcn_readfirstlane((int)threadIdx.x >> 6);
    if (ph_hi - ph_lo > 1) {
        volatile LAS unsigned* st = (volatile LAS unsigned*)(lds + LDS_MAIN);
        if (threadIdx.x == 0) { st[0] = 0u; st[1] = 0u; }
        __syncthreads();
        (void)xcd_barrier_post((unsigned*)(load_params().ws + WS_BAR), st);
    }
    int nseam = 0;
    for (int ph2 = 2 * ph_lo; ph2 < 2 * ph_hi; ++ph2) {
        const int ph = ph2 >> 1; const bool dry = (ph2 & 1);
        if (ph == 8 || ph == 3) continue;
        if ((ph2 & 1) && !((REPMASK >> ph) & 1)) continue;
#define WL() const int tid = ltid(wv0), wave = __builtin_amdgcn_readfirstlane(tid >> 6), lane = tid & 63; (void)lane; (void)wave
#define GW() const int gw = lbid() * NWAVES + wave, ngw = gridDim.x * NWAVES
        switch (ph) {
        case 0: if (EN(0)) { const P p = load_params(); WL(); prep_phase(p, lds, wave, lane); } break;
        case 1: if (EN(1)) { const P p = load_params(); unsigned char* ws = p.ws;
                  pg8::Gemm g{(const bf16_t*)(ws + WS_HN), (const bf16_t*)(ws + WS_WIN), MTOK, 2 * DM, DM}; pg8::StaticOrder S; S.init(MTOK, 2 * DM, gridDim.x, lbid());
                  pg8::EpiWin E{(bf16_t*)(ws + WS_GATE), (bf16_t*)(ws + WS_RECPRE), (const float*)(ws + WS_PART)}; pg8::gemm_phase(lds, g, S, E, wv0); } break;
        case 2: if (EN(2)) { const P p = load_params(); lru_phase(p, lds, wv0); } break;
        case 3: if (EN(3)) { const P p = load_params(); ycomb_phase(p, wv0); } break;
        case 4: case 6: case 10: case 12: if (EN(4)) {
            const P p = load_params(); unsigned char* ws = p.ws;
            const bf16_t* A = (const bf16_t*)(ws + (ph == 4 ? WS_Y : (ph == 10 ? WS_Q : WS_U)));
            const bf16_t* Bt = (const bf16_t*)(ws + (ph == 4 ? WS_WOUT : ph == 6 ? WS_WDN0 : ph == 10 ? WS_WO : WS_WDN1));
            const int K = (ph == 6 || ph == 12) ? DFF : DM;
            pg8::Gemm g{A, Bt, MTOK, DM, K}; pg8::StaticOrder S; S.init(MTOK, DM, gridDim.x, lbid());
            pg8::EpiResid E{(bf16_t*)(ws + (dry ? WS_HB : WS_HN)), (float*)(ws + (dry ? WS_HB : WS_PART)), ph != 12}; pg8::gemm_phase(lds, g, S, E, wv0); } break;
        case 5: case 11: if (EN(5)) {
            const P p = load_params(); unsigned char* ws = p.ws;
            pg8::Gemm g{(const bf16_t*)(ws + WS_HN), (const bf16_t*)(ws + (ph == 5 ? WS_WUP0 : WS_WUP1)), MTOK, DFF, DM}; pg8::StaticOrder S; S.init(MTOK, DFF, gridDim.x, lbid());
            pg8::EpiRelu2 E{(bf16_t*)(ws + WS_U), (const float*)(ws + WS_PART)}; pg8::gemm_phase(lds, g, S, E, wv0); } break;
        case 7: if (EN(7)) { const P p = load_params(); unsigned char* ws = p.ws;
                  pg8::Gemm g{(const bf16_t*)(ws + WS_HN), (const bf16_t*)(ws + WS_WQKV), MTOK, NQKV, DM}; pg8::StaticOrder S; S.init(MTOK, NQKV, gridDim.x, lbid());
                  pg8::EpiQKV E{ws, (const float*)(ws + WS_PART)}; pg8::gemm_phase(lds, g, S, E, wv0);
                  asm volatile("s_waitcnt vmcnt(0)" ::: "memory"); __syncthreads(); __builtin_amdgcn_fence(__ATOMIC_ACQUIRE, "agent"); asm volatile("s_waitcnt vmcnt(0)" ::: "memory");
                  pg8::Unit u; WL();
                  for (int i = 0; S.next(i, u); ++i) { if (u.pn == 4)
                          rope_tile((bf16_t*)(ws + WS_K) + (size_t)u.pm * 256 * NKV, NKV, u.pm * 256, p.in[I_KG], wave, lane); } } break;
        case 8: if (EN(8)) { const P p = load_params(); WL(); rope_phase(p, wave, lane, dry); } break;
        case 9: if (EN(9)) { const P p = load_params(); attn_phase(p, (char*)shm, dry, wv0); } break;
        case 13: if (EN(13)) { const P p = load_params(); WL(); GW(); final_norm_rows((const bf16_t*)(p.ws + WS_HN), p.in[I_FG], p.out, gw, ngw, lane); } break;
        default: break;
        }
        if ((((ph2 & 1) == 0) && ((REPMASK >> ph) & 1)) || ph + 1 < ph_hi) { if (ph_hi < 0) grid.sync();   { XcdBarrier xb2; xb2.bar = (unsigned*)(load_params().ws + WS_BAR); xb2.x = xb_xcc_id(); xb2.st = (volatile LAS unsigned*)(lds + LDS_MAIN); xcd_barrier(xb2, wv0); } ++nseam; }
    }
}

extern "C" void kernel_launch(void* const* d_in, const int* in_sizes, int n_in, void* d_out, int out_size, void* d_ws, size_t ws_size, hipStream_t stream) {
    static int grid = 0;
    if (grid == 0) {
        if (n_in != 19 || out_size != MTOK * DM || ws_size < WS_END) { fprintf(stderr, "kernel_launch: unexpected shapes n_in %d out %d ws %zu\n", n_in, out_size, ws_size); grid = -1; return; }
        int dev = 0, cus = 0, per_cu = 0;
        hipGetDevice(&dev);
        hipDeviceGetAttribute(&cus, hipDeviceAttributeMultiprocessorCount, dev);
        if (hipFuncSetAttribute((const void*)mega, hipFuncAttributeMaxDynamicSharedMemorySize, LDS_BYTES) != hipSuccess) { fprintf(stderr, "kernel_launch: hipFuncSetAttribute failed\n"); grid = -1; return; }
        hipOccupancyMaxActiveBlocksPerMultiprocessor(&per_cu, (const void*)mega, NTHREADS, LDS_BYTES);
        if (per_cu < 1) per_cu = 1;
        grid = cus * per_cu;
        (void)hipGetLastError();
    }
    if (grid < 0) return;
    P p{};
    for (int i = 0; i < 19; ++i) p.in[i] = (const float*)d_in[i];
    p.out = (float*)d_out; p.ws = (unsigned char*)d_ws;
#if ONE_LAUNCH
    p.ph_lo = 0; p.ph_hi = NPHASE;
    if (hipMemsetAsync((char*)d_ws + WS_BAR, 0, XCD_BAR_WORDS * 4, stream) != hipSuccess) { fprintf(stderr, "kernel_launch: memset of the barrier words failed\n"); return; }
    void* args[] = {&p};
    hipError_t e = hipLaunchCooperativeKernel((const void*)mega, dim3(grid), dim3(NTHREADS), args, LDS_BYTES, stream);
    if (e != hipSuccess) fprintf(stderr, "cooperative launch failed: %s (grid %d)\n", hipGetErrorString(e), grid);
#else
    for (int ph = 0; ph < NPHASE; ++ph) {
        p.ph_lo = ph; p.ph_hi = ph + 1;
        hipLaunchKernelGGL(mega, dim3(grid), dim3(NTHREADS), LDS_BYTES, stream, p);
    }
#endif
}
```

```cpp
#include <hip/hip_runtime.h>
#include <hip/hip_cooperative_groups.h>
#include <cstdio>
#include <cstdint>
namespace cg = cooperative_groups;

#ifndef ONE_LAUNCH
#define ONE_LAUNCH 1
#endif

#define LAS __attribute__((address_space(3)))
typedef unsigned short bf16_t;
typedef short bf16x8 __attribute__((ext_vector_type(8)));
typedef short s16x4 __attribute__((ext_vector_type(4)));
typedef float f32x4 __attribute__((ext_vector_type(4)));
typedef float f32x2 __attribute__((ext_vector_type(2)));
typedef float f32x16 __attribute__((ext_vector_type(16)));
typedef unsigned u32x4 __attribute__((ext_vector_type(4)));
typedef unsigned u32x2 __attribute__((ext_vector_type(2)));

constexpr int BATCH = 16, SEQ = 2048, DM = 1024, MTOK = BATCH * SEQ, DFF = 4096, NQKV = 1536, NKV = 256;
constexpr float EPS = 1e-6f;
constexpr int NTHREADS = 512, NWAVES = 8;
constexpr int LDS_MAIN = 131072;
constexpr int LDS_RS = LDS_MAIN + 16;
constexpr int LDS_BYTES = LDS_RS + 2048;

constexpr size_t MiB = 1024 * 1024;
constexpr size_t WS_WIN = 0, WS_WOUT = 4 * MiB, WS_WQKV = 6 * MiB, WS_WO = 9 * MiB, WS_WUP0 = 11 * MiB, WS_WUP1 = 19 * MiB,
                 WS_WDN0 = 27 * MiB, WS_WDN1 = 35 * MiB, WS_WG = 43 * MiB, WS_PART = 44 * MiB, WS_BAR = 46 * MiB, WS_HN = 48 * MiB, WS_U = 112 * MiB;
constexpr size_t WS_GATE = WS_U, WS_RECPRE = WS_U + 64 * MiB, WS_Y = WS_U + 128 * MiB, WS_HF = WS_U + 192 * MiB, WS_HB = WS_U + 256 * MiB;
constexpr size_t WS_Q = WS_U, WS_K = WS_U + 64 * MiB, WS_V = WS_U + 80 * MiB;
constexpr size_t WS_END = WS_U + 320 * MiB;

struct P {
    const float* in[19];
    float* out;
    unsigned char* ws;
    int ph_lo, ph_hi;
};
enum { I_X = 0, I_GMIX, I_GMLP, I_WIN, I_CONVW, I_CONVB, I_WA, I_BA, I_WX, I_BX, I_LAM, I_WOUT, I_WQKV, I_QG, I_KG, I_WO, I_WUP, I_WDN, I_FG };

__device__ __forceinline__ int ltid(int wv) { int t = wv * 64 + (int)__builtin_amdgcn_mbcnt_hi(~0u, __builtin_amdgcn_mbcnt_lo(~0u, 0u)); asm volatile("" : "+v"(t)); return t; }
__device__ __forceinline__ int lbid() { int b = blockIdx.x; asm volatile("" : "+s"(b)); return b; }
__device__ __forceinline__ unsigned pk2(float lo, float hi) { unsigned r; asm("v_cvt_pk_bf16_f32 %0, %1, %2" : "=v"(r) : "v"(lo), "v"(hi)); return r; }
__device__ __forceinline__ float bflo(unsigned w) { return __uint_as_float(w << 16); }
__device__ __forceinline__ float bfhi(unsigned w) { return __uint_as_float(w & 0xffff0000u); }
template <int K> __device__ __forceinline__ float lane_xor(float v) { return __int_as_float(__builtin_amdgcn_ds_swizzle(__float_as_int(v), (K << 10) | 0x1f)); }
__device__ __forceinline__ float sum_xor32(float v) { auto rr = __builtin_amdgcn_permlane32_swap(__float_as_uint(v), __float_as_uint(v), false, false); return __uint_as_float(rr[0]) + __uint_as_float(rr[1]); }
__device__ __forceinline__ float wave_sum(float v) {
    v += lane_xor<1>(v); v += lane_xor<2>(v); v += lane_xor<4>(v); v += lane_xor<8>(v); v += lane_xor<16>(v);
    return sum_xor32(v);
}
__device__ __forceinline__ float fsigmoid(float z) { return __builtin_amdgcn_rcpf(1.0f + __builtin_amdgcn_exp2f(-1.4426950408889634f * z)); }

namespace pg8 {
constexpr int BM = 256, BK = 64, HALF = 128, HTB = HALF * BK * 2, STAGE_BYTES = 8 * HTB, NXCD = 8, WGM = 8;
__host__ __device__ __forceinline__ int lds_byte(int r, int c) { const int st = (r >> 4) * 2 + (c >> 5), rr = r & 15, cc = c & 31, ob = rr * 64 + cc * 2; return st * 1024 + (ob ^ (((ob >> 9) & 1) << 5)); }
__host__ __device__ __forceinline__ void stage_rc(int b, int& R, int& C) { const int st = b / 1024, sb = b % 1024, swz = sb ^ (((sb >> 9) & 1) << 5); R = (st >> 1) * 16 + swz / 64; C = (st & 1) * 32 + (swz % 64) / 2; }
__host__ __device__ __forceinline__ int perm32(int rho) { const int n = rho >> 4, i = rho & 15; return 8 * (i >> 2) + 4 * n + (i & 3); }
struct Unit { int pm, pn; };
struct Gemm { const bf16_t* A; const bf16_t* Bt; int M, N, K; };
struct StaticOrder {
    int nM, nN, nwg, G, c;
    __device__ void init(int M, int N, int G_, int c_) { nM = M / BM; nN = N / BM; nwg = nM * nN; G = G_; c = c_; }
    __device__ bool next(int i, Unit& u) const {
        const long L = (long)i * G + c; if (L >= nwg) return false;
        int wgid = (int)L; { const int q = nwg / NXCD, r = nwg % NXCD, xcd = wgid % NXCD, off = wgid / NXCD; wgid = (xcd < r ? xcd * (q + 1) : r * (q + 1) + (xcd - r) * q) + off; }
        const int nig = WGM * nN, gid = wgid / nig, fm = gid * WGM, gsz = (nM - fm) < WGM ? (nM - fm) : WGM;
        u.pm = fm + ((wgid % nig) % gsz); u.pn = (wgid % nig) / gsz; return true;
    }
};

__device__ __forceinline__ void row_scales_load(const float* part, int row0, int fq, f32x4 (&t)[2][4]);
__device__ __forceinline__ void row_scales_reduce(const f32x4 (&t)[2][4], float (&rs)[2][4]);
template <class Epi>
__device__ __forceinline__ void gemm_phase(LAS unsigned char* lds, const Gemm g, const StaticOrder& S, const Epi& E, int wv) {
    const int tid = ltid(wv), wid = __builtin_amdgcn_readfirstlane(tid >> 6), lane = tid & 63, wr = wid >> 2, wc = wid & 3, fr = lane & 15, fq = lane >> 4;
    const int K = g.K, nt = K / BK;
    unsigned voffA[2], voffB[2];
#pragma unroll
    for (int i = 0; i < 2; ++i) { int R, C; stage_rc(tid * 16 + i * 8192, R, C); const int Rb = Epi::PERM ? ((R & ~31) + perm32(R & 31)) : R;
        voffA[i] = (unsigned)(R * K + C) * 2u; voffB[i] = (unsigned)(Rb * K + C) * 2u; }
    const size_t kstep = (size_t)(BK * 2);
    const size_t hstep = (size_t)HALF * K * 2;
    const size_t tstep = 2 * hstep;
    const unsigned ldsw = (unsigned)wid * 1024u;
    const int aoff = lds_byte(wr * 64 + fr, fq * 8), boff = lds_byte(wc * 32 + fr, fq * 8);
#define PG8_SA(b, h) (((b) * 2 + (h)) * HTB)
#define PG8_SB(b, h) ((4 + (b) * 2 + (h)) * HTB)
#define PG8_STAGE(bufoff, gbase, voff) do { _Pragma("unroll") for (int _i = 0; _i < 2; ++_i) \
        __builtin_amdgcn_global_load_lds((const unsigned*)((const char*)(gbase) + (voff)[_i]), (LAS unsigned*)(lds + (bufoff) + ldsw + _i * 8192), 16, 0, 0); } while (0)
#define PG8_LDA(dst, b, h) do { _Pragma("unroll") for (int m = 0; m < 4; ++m) _Pragma("unroll") for (int k = 0; k < 2; ++k) dst[m][k] = *(const LAS bf16x8*)(lds + PG8_SA(b, h) + aoff + m * 2048 + k * 1024); } while (0)
#define PG8_LDB(dst, b, h) do { _Pragma("unroll") for (int n = 0; n < 2; ++n) _Pragma("unroll") for (int k = 0; k < 2; ++k) dst[n][k] = *(const LAS bf16x8*)(lds + PG8_SB(b, h) + boff + n * 2048 + k * 1024); } while (0)
#define PG8_MMA(ai, bj, At, Bt) do { __builtin_amdgcn_s_setprio(1); _Pragma("unroll") for (int m = 0; m < 4; ++m) _Pragma("unroll") for (int n = 0; n < 2; ++n) _Pragma("unroll") for (int k = 0; k < 2; ++k) \
        acc[ai][bj][m][n] = __builtin_amdgcn_mfma_f32_16x16x32_bf16(Bt[n][k], At[m][k], acc[ai][bj][m][n], 0, 0, 0); __builtin_amdgcn_s_setprio(0); } while (0)
#define PG8_WAIT_V(n) asm volatile("s_waitcnt vmcnt(" #n ")" ::: "memory")
#define PG8_WAIT_L(n) asm volatile("s_waitcnt lgkmcnt(" #n ")" ::: "memory")
#define PG8_BAR __builtin_amdgcn_s_barrier()
#define PG8_SCHED __builtin_amdgcn_sched_barrier(0)
    Unit cur, nxt; int ui = 0;
    if (!S.next(0, cur)) return;
    f32x4 acc[2][2][4][2];
#pragma unroll
    for (int a = 0; a < 2; ++a)
#pragma unroll
        for (int b = 0; b < 2; ++b)
#pragma unroll
            for (int m = 0; m < 4; ++m)
#pragma unroll
                for (int n = 0; n < 2; ++n) acc[a][b][m][n] = (f32x4){0.f, 0.f, 0.f, 0.f};
    bf16x8 At[4][2], B0[2][2], B1[2][2];
    const char* cA = (const char*)g.A + (size_t)cur.pm * tstep; const char* cB = (const char*)g.Bt + (size_t)cur.pn * tstep;
    LAS float* rsl = (LAS float*)(lds + LDS_RS);
#define PG8_RS_LOAD(pm_, ta, tb) do { const float* _pp = E.part + ((size_t)(pm_) * BM + wid * 32 + (lane >> 1)) * 16 + (lane & 1) * 8; ta = *(const f32x4*)_pp; tb = *(const f32x4*)(_pp + 4); } while (0)
#define PG8_RS_PUBLISH(ta, tb, par) do { float _ss = ((ta[0] + ta[1]) + (ta[2] + ta[3])) + ((tb[0] + tb[1]) + (tb[2] + tb[3])); _ss += lane_xor<1>(_ss); \
        if (!(lane & 1)) rsl[(par) * 256 + wid * 32 + (lane >> 1)] = rsqrtf(_ss * (1.f / DM) + EPS); } while (0)
    f32x4 ta0, tb0; if constexpr (Epi::ROWSCALE) PG8_RS_LOAD(cur.pm, ta0, tb0);
    PG8_STAGE(PG8_SB(0, 0), cB, voffB); PG8_STAGE(PG8_SA(0, 0), cA, voffA); PG8_STAGE(PG8_SB(0, 1), cB + hstep, voffB); PG8_STAGE(PG8_SA(0, 1), cA + hstep, voffA);
    if (wr == 1) PG8_BAR;
    PG8_WAIT_V(4); PG8_BAR;
    PG8_STAGE(PG8_SB(1, 0), cB + kstep, voffB); PG8_STAGE(PG8_SA(1, 0), cA + kstep, voffA); PG8_STAGE(PG8_SB(1, 1), cB + hstep + kstep, voffB);
    PG8_WAIT_V(6); PG8_BAR;
    if constexpr (Epi::ROWSCALE) PG8_RS_PUBLISH(ta0, tb0, 0);
    for (;;) {
        const bool has_next = S.next(ui + 1, nxt);
        const char* nA = has_next ? (const char*)g.A + (size_t)nxt.pm * tstep : cA; const char* nB = has_next ? (const char*)g.Bt + (size_t)nxt.pn * tstep : cB;
        for (int t = 0; t < nt; t += 2) {
            const bool last = (t == nt - 2);
            const char* a1 = cA + (size_t)(t + 1) * kstep;
            const char* a2 = last ? nA : cA + (size_t)(t + 2) * kstep; const char* b2 = last ? nB : cB + (size_t)(t + 2) * kstep;
            const char* a3 = a2 + kstep; const char* b3 = b2 + kstep;
            PG8_LDB(B0, 0, 0); PG8_SCHED; PG8_LDA(At, 0, 0); PG8_STAGE(PG8_SA(1, 1), a1 + hstep, voffA);
            PG8_WAIT_L(8); PG8_BAR; PG8_WAIT_L(0); PG8_MMA(0, 0, At, B0); PG8_BAR; PG8_SCHED;
            PG8_LDB(B1, 0, 1); PG8_STAGE(PG8_SB(0, 0), b2, voffB);
            PG8_BAR; PG8_WAIT_L(0); PG8_MMA(0, 1, At, B1); PG8_BAR;
            PG8_LDA(At, 0, 1); PG8_STAGE(PG8_SA(0, 0), a2, voffA);
            PG8_BAR; PG8_WAIT_L(0); PG8_MMA(1, 0, At, B0); PG8_BAR; PG8_SCHED;
            PG8_STAGE(PG8_SB(0, 1), b2 + hstep, voffB);
            PG8_WAIT_V(6); PG8_BAR; PG8_MMA(1, 1, At, B1); PG8_BAR;
            PG8_LDB(B0, 1, 0); PG8_SCHED; PG8_LDA(At, 1, 0); PG8_STAGE(PG8_SA(0, 1), a2 + hstep, voffA);
            PG8_WAIT_L(8); PG8_BAR; PG8_WAIT_L(0); PG8_MMA(0, 0, At, B0); PG8_BAR; PG8_SCHED;
            PG8_LDB(B1, 1, 1); PG8_STAGE(PG8_SB(1, 0), b3, voffB);
            PG8_BAR; PG8_WAIT_L(0); PG8_MMA(0, 1, At, B1); PG8_BAR;
            PG8_LDA(At, 1, 1); PG8_STAGE(PG8_SA(1, 0), a3, voffA);
            PG8_BAR; PG8_WAIT_L(0); PG8_MMA(1, 0, At, B0); PG8_BAR; PG8_SCHED;
            PG8_STAGE(PG8_SB(1, 1), b3 + hstep, voffB);
            PG8_WAIT_V(6); PG8_BAR; PG8_MMA(1, 1, At, B1); PG8_BAR;
        }
        if constexpr (Epi::ROWSCALE) { f32x4 ta, tb; if (has_next) PG8_RS_LOAD(nxt.pm, ta, tb);
            E(acc, cur, wr, wc, fr, fq, rsl + (ui & 1) * 256); if (has_next) PG8_RS_PUBLISH(ta, tb, (ui + 1) & 1); }
        else E(acc, cur, wr, wc, fr, fq, rsl);
        if (!has_next) break;
#pragma unroll
        for (int a = 0; a < 2; ++a)
#pragma unroll
            for (int b = 0; b < 2; ++b)
#pragma unroll
                for (int m = 0; m < 4; ++m)
#pragma unroll
                    for (int n = 0; n < 2; ++n) acc[a][b][m][n] = (f32x4){0.f, 0.f, 0.f, 0.f};
        cur = nxt; cA = nA; cB = nB; ++ui;
    }
    PG8_WAIT_V(0);
    if (wr == 0) PG8_BAR;
    PG8_BAR;
#undef PG8_RS_PUBLISH
#undef PG8_RS_LOAD
#undef PG8_SA
#undef PG8_SB
#undef PG8_STAGE
#undef PG8_LDA
#undef PG8_LDB
#undef PG8_MMA
#undef PG8_WAIT_V
#undef PG8_WAIT_L
#undef PG8_BAR
#undef PG8_SCHED
}

__device__ __forceinline__ float gelu_tanh(float x) {
    const float y = 1.5957691216057308f * (x + 0.044715f * x * x * x);
    return x * fsigmoid(y);
}
template <int MODE> __device__ __forceinline__ void store8(bf16_t* p, f32x4 v0, f32x4 v1, float rs) {
    f32x2 a = {v0[0], v0[1]}, b = {v0[2], v0[3]}, c = {v1[0], v1[1]}, d = {v1[2], v1[3]};
    a = a * rs; b = b * rs; c = c * rs; d = d * rs;
    if (MODE == 1) {
        a.x = gelu_tanh(a.x); a.y = gelu_tanh(a.y); b.x = gelu_tanh(b.x); b.y = gelu_tanh(b.y); c.x = gelu_tanh(c.x); c.y = gelu_tanh(c.y); d.x = gelu_tanh(d.x); d.y = gelu_tanh(d.y);
    }
    if (MODE == 2) {
        const f32x2 z = {0.f, 0.f};
        a = __builtin_elementwise_max(a, z); b = __builtin_elementwise_max(b, z); c = __builtin_elementwise_max(c, z); d = __builtin_elementwise_max(d, z);
        a = a * a; b = b * b; c = c * c; d = d * d;
    }
    u32x4 w; w.x = pk2(a.x, a.y); w.y = pk2(b.x, b.y); w.z = pk2(c.x, c.y); w.w = pk2(d.x, d.y);
    *(u32x4*)p = w;
}
__device__ __forceinline__ float row_rs(const float* part, int row) {
    const f32x4* pp = (const f32x4*)(part + (size_t)row * 16); const f32x4 a = pp[0], b = pp[1], c = pp[2], d = pp[3];
    const float ss = ((a[0] + a[1]) + (a[2] + a[3])) + ((b[0] + b[1]) + (b[2] + b[3])) + ((c[0] + c[1]) + (c[2] + c[3])) + ((d[0] + d[1]) + (d[2] + d[3]));
    return rsqrtf(ss * (1.f / DM) + EPS);
}
__device__ __forceinline__ void row_scales_load(const float* part, int row0, int fq, f32x4 (&t)[2][4]) {
#pragma unroll
    for (int ai = 0; ai < 2; ++ai)
#pragma unroll
        for (int m = 0; m < 4; ++m) t[ai][m] = *(const f32x4*)(part + (size_t)(row0 + ai * HALF + m * 16) * 16 + fq * 4);
}
__device__ __forceinline__ void row_scales_reduce(const f32x4 (&t)[2][4], float (&rs)[2][4]) {
#pragma unroll
    for (int ai = 0; ai < 2; ++ai)
#pragma unroll
        for (int m = 0; m < 4; ++m) { float ss = (t[ai][m][0] + t[ai][m][1]) + (t[ai][m][2] + t[ai][m][3]); ss += lane_xor<16>(ss); ss = sum_xor32(ss); rs[ai][m] = rsqrtf(ss * (1.f / DM) + EPS); }
}
struct EpiWin {
    static constexpr bool PERM = true, ROWSCALE = true;
    bf16_t* gate; bf16_t* rec; const float* part;
    __device__ __forceinline__ void operator()(const f32x4 (&acc)[2][2][4][2], const Unit& u, int wr, int wc, int fr, int fq, const LAS float* rsl) const {
        const int row0 = u.pm * BM + wr * 64 + fr; const bool isg = u.pn < 4; bf16_t* base = isg ? gate : rec;
        const int col0 = (u.pn & 3) * BM + wc * 32 + 8 * fq;
#pragma unroll
        for (int ai = 0; ai < 2; ++ai)
#pragma unroll
            for (int m = 0; m < 4; ++m) { bf16_t* rowp = base + (size_t)(row0 + ai * HALF + m * 16) * DM + col0; const float rs = rsl[ai * HALF + wr * 64 + m * 16 + fr];
#pragma unroll
                for (int bj = 0; bj < 2; ++bj) { if (isg) store8<1>(rowp + bj * HALF, acc[ai][bj][m][0], acc[ai][bj][m][1], rs); else store8<0>(rowp + bj * HALF, acc[ai][bj][m][0], acc[ai][bj][m][1], rs); } }
    }
};
struct EpiRelu2 {
    static constexpr bool PERM = true, ROWSCALE = true;
    bf16_t* U; const float* part;
    __device__ __forceinline__ void operator()(const f32x4 (&acc)[2][2][4][2], const Unit& u, int wr, int wc, int fr, int fq, const LAS float* rsl) const {
        const int row0 = u.pm * BM + wr * 64 + fr; const int col0 = u.pn * BM + wc * 32 + 8 * fq;
#pragma unroll
        for (int ai = 0; ai < 2; ++ai)
#pragma unroll
            for (int m = 0; m < 4; ++m) { const int row = row0 + ai * HALF + m * 16; bf16_t* rowp = U + (size_t)row * DFF + col0;
                const float rs = rsl[ai * HALF + wr * 64 + m * 16 + fr];
#pragma unroll
                for (int bj = 0; bj < 2; ++bj) store8<2>(rowp + bj * HALF, acc[ai][bj][m][0], acc[ai][bj][m][1], rs); }
    }
};
struct EpiQKV {
    static constexpr bool PERM = true, ROWSCALE = true;
    unsigned char* ws; const float* part;
    __device__ __forceinline__ void operator()(const f32x4 (&acc)[2][2][4][2], const Unit& u, int wr, int wc, int fr, int fq, const LAS float* rsl) const {
        const int row0 = u.pm * BM + wr * 64 + fr;
        const bool isq = u.pn < 4; bf16_t* base = (bf16_t*)(ws + WS_Q + (isq ? (size_t)0 : (size_t)(64 + 16 * (u.pn - 4)) * MiB)); const int ldc = isq ? DM : NKV; const int colt = isq ? u.pn * BM : 0;
        const int col0 = colt + wc * 32 + 8 * fq;
#pragma unroll
        for (int ai = 0; ai < 2; ++ai)
#pragma unroll
            for (int m = 0; m < 4; ++m) { const int row = row0 + ai * HALF + m * 16; bf16_t* rowp = base + (size_t)row * ldc + col0;
                const float rs = rsl[ai * HALF + wr * 64 + m * 16 + fr];
#pragma unroll
                for (int bj = 0; bj < 2; ++bj) store8<0>(rowp + bj * HALF, acc[ai][bj][m][0], acc[ai][bj][m][1], rs); }
    }
};
struct EpiResid {
    static constexpr bool PERM = true, ROWSCALE = false;
    bf16_t* xb; float* part; int stats;
    __device__ __forceinline__ void operator()(const f32x4 (&acc)[2][2][4][2], const Unit& u, int wr, int wc, int fr, int fq, const LAS float* rsl) const {
        const int row0 = u.pm * BM + wr * 64 + fr, col0 = u.pn * BM + wc * 32 + 8 * fq;
        u32x4 bsa[2][4][2];
#pragma unroll
        for (int ai = 0; ai < 2; ++ai)
#pragma unroll
            for (int m = 0; m < 4; ++m)
#pragma unroll
                for (int bj = 0; bj < 2; ++bj) bsa[ai][m][bj] = *(const u32x4*)(xb + (size_t)(row0 + ai * HALF + m * 16) * DM + col0 + bj * HALF);
        asm volatile("" ::: "memory");
#pragma unroll
        for (int ai = 0; ai < 2; ++ai)
#pragma unroll
            for (int m = 0; m < 4; ++m) { const int row = row0 + ai * HALF + m * 16; bf16_t* rowp = xb + (size_t)row * DM + col0;
                float ss = 0.f;
#pragma unroll
                for (int bj = 0; bj < 2; ++bj) { const u32x4 b = bsa[ai][m][bj]; const f32x4 a0 = acc[ai][bj][m][0], a1 = acc[ai][bj][m][1];
                    const float v0 = bflo(b.x) + a0[0], v1 = bfhi(b.x) + a0[1], v2 = bflo(b.y) + a0[2], v3 = bfhi(b.y) + a0[3];
                    const float v4 = bflo(b.z) + a1[0], v5 = bfhi(b.z) + a1[1], v6 = bflo(b.w) + a1[2], v7 = bfhi(b.w) + a1[3];
                    ss += ((v0 * v0 + v1 * v1) + (v2 * v2 + v3 * v3)) + ((v4 * v4 + v5 * v5) + (v6 * v6 + v7 * v7));
                    u32x4 w; w.x = pk2(v0, v1); w.y = pk2(v2, v3); w.z = pk2(v4, v5); w.w = pk2(v6, v7);
                    *(u32x4*)(rowp + bj * HALF) = w; }
                if (stats) { ss += lane_xor<16>(ss); ss = sum_xor32(ss); if (fq == 0) part[(size_t)row * 16 + u.pn * 4 + wc] = ss; } }
    }
};
}

__device__ __forceinline__ void transpose_item(const float* W, int K, int N, bf16_t* WT, int row_off, LAS float* scr, int item, int lane, const float* gk = nullptr) {
    const int nblk = N / 32, kb = item / nblk, nb = item % nblk, k0 = 64 * kb, n0 = 32 * nb;
    float tv[32];
#pragma unroll
    for (int i = 0; i < 32; ++i) tv[i] = W[(size_t)(k0 + 2 * i + (lane >> 5)) * N + n0 + (lane & 31)];
#pragma unroll
    for (int i = 0; i < 32; ++i) scr[(2 * i + (lane >> 5)) * 33 + (lane & 31)] = tv[i];
    asm volatile("s_waitcnt lgkmcnt(0)" ::: "memory");
    const int c = lane & 7;
#pragma unroll
    for (int j = 0; j < 4; ++j) { const int n = (lane >> 3) + 8 * j; const LAS float* s = scr + (8 * c) * 33 + n;
        f32x4 g0 = (f32x4){1.f, 1.f, 1.f, 1.f}, g1 = g0; if (gk) { g0 = *(const f32x4*)(gk + k0 + 8 * c); g1 = *(const f32x4*)(gk + k0 + 8 * c + 4); }
        u32x4 o; o.x = pk2(s[0 * 33] * g0[0], s[1 * 33] * g0[1]); o.y = pk2(s[2 * 33] * g0[2], s[3 * 33] * g0[3]); o.z = pk2(s[4 * 33] * g1[0], s[5 * 33] * g1[1]); o.w = pk2(s[6 * 33] * g1[2], s[7 * 33] * g1[3]);
        *(u32x4*)(WT + (size_t)(row_off + n0 + n) * K + k0 + 8 * c) = o; }
    asm volatile("s_waitcnt lgkmcnt(0)" ::: "memory");
}
__device__ __forceinline__ void norm_rows_bf16(const float* src, const float* g, bf16_t* dst, int gw, int ngw, int lane) {
    f32x4 gv[4];
#pragma unroll
    for (int j = 0; j < 4; ++j) gv[j] = *((const f32x4*)g + lane + 64 * j);
    for (int m = gw; m < MTOK; m += ngw) {
        const f32x4* xr = (const f32x4*)(src + (size_t)m * DM) + lane;
        f32x4 v[4]; float s = 0.f;
#pragma unroll
        for (int j = 0; j < 4; ++j) { v[j] = xr[64 * j]; s += (v[j].x * v[j].x + v[j].y * v[j].y) + (v[j].z * v[j].z + v[j].w * v[j].w); }
        const float rs = rsqrtf(wave_sum(s) * (1.f / DM) + EPS);
        u32x2* o8 = (u32x2*)(dst + (size_t)m * DM) + lane;
#pragma unroll
        for (int j = 0; j < 4; ++j) { u32x2 w; w.x = pk2(v[j].x * rs * gv[j].x, v[j].y * rs * gv[j].y); w.y = pk2(v[j].z * rs * gv[j].z, v[j].w * rs * gv[j].w); o8[64 * j] = w; }
    }
}
__device__ __forceinline__ void xb_rows(const float* src, bf16_t* dst, float* part, int gw, int ngw, int lane) {
    for (int m = 4 * gw; m < MTOK; m += 4 * ngw) {
        f32x4 v[4][4];
#pragma unroll
        for (int u = 0; u < 4; ++u)
#pragma unroll
            for (int j = 0; j < 4; ++j) v[u][j] = __builtin_nontemporal_load((const f32x4*)(src + (size_t)(m + u) * DM) + lane + 64 * j);
#pragma unroll
        for (int u = 0; u < 4; ++u) {
            float s = 0.f;
#pragma unroll
            for (int j = 0; j < 4; ++j) s += (v[u][j].x * v[u][j].x + v[u][j].y * v[u][j].y) + (v[u][j].z * v[u][j].z + v[u][j].w * v[u][j].w);
            s = wave_sum(s);
            u32x2* o8 = (u32x2*)(dst + (size_t)(m + u) * DM) + lane;
#pragma unroll
            for (int j = 0; j < 4; ++j) { u32x2 w; w.x = pk2(v[u][j].x, v[u][j].y); w.y = pk2(v[u][j].z, v[u][j].w); o8[64 * j] = w; }
            if (lane < 16) part[(size_t)(m + u) * 16 + lane] = lane == 0 ? s : 0.f;
        }
    }
}
__device__ __forceinline__ void final_norm_rows(const bf16_t* src, const float* g, float* dst, int gw, int ngw, int lane) {
    f32x4 gv[4];
#pragma unroll
    for (int j = 0; j < 4; ++j) gv[j] = *((const f32x4*)g + lane + 64 * j);
    for (int m = 4 * gw; m < MTOK; m += 4 * ngw) {
        u32x2 w[4][4];
#pragma unroll
        for (int u = 0; u < 4; ++u)
#pragma unroll
            for (int j = 0; j < 4; ++j) w[u][j] = *((const u32x2*)(src + (size_t)(m + u) * DM) + lane + 64 * j);
#pragma unroll
        for (int u = 0; u < 4; ++u) {
            f32x4 v[4]; float s = 0.f;
#pragma unroll
            for (int j = 0; j < 4; ++j) { v[j] = (f32x4){bflo(w[u][j].x), bfhi(w[u][j].x), bflo(w[u][j].y), bfhi(w[u][j].y)}; s += (v[j].x * v[j].x + v[j].y * v[j].y) + (v[j].z * v[j].z + v[j].w * v[j].w); }
            const float rs = rsqrtf(wave_sum(s) * (1.f / DM) + EPS);
            f32x4* o = (f32x4*)(dst + (size_t)(m + u) * DM) + lane;
#pragma unroll
            for (int j = 0; j < 4; ++j) __builtin_nontemporal_store(v[j] * rs * gv[j], o + 64 * j);
        }
    }
}
__device__ __forceinline__ void norm_rows_f32_inplace(float* buf, const float* g, int gw, int ngw, int lane) {
    f32x4 gv[4];
#pragma unroll
    for (int j = 0; j < 4; ++j) gv[j] = *((const f32x4*)g + lane + 64 * j);
    for (int m = gw; m < MTOK; m += ngw) {
        f32x4* xr = (f32x4*)(buf + (size_t)m * DM) + lane;
        f32x4 v[4]; float s = 0.f;
#pragma unroll
        for (int j = 0; j < 4; ++j) { v[j] = xr[64 * j]; s += (v[j].x * v[j].x + v[j].y * v[j].y) + (v[j].z * v[j].z + v[j].w * v[j].w); }
        const float rs = rsqrtf(wave_sum(s) * (1.f / DM) + EPS);
#pragma unroll
        for (int j = 0; j < 4; ++j) xr[64 * j] = v[j] * rs * gv[j];
    }
}

__device__ __forceinline__ void prep_phase(const P& p, LAS unsigned char* lds, int wave, int lane) {
    LAS float* scr = (LAS float*)(lds + wave * 16384);
    const int gw = lbid() * NWAVES + wave, ngw = gridDim.x * NWAVES;
    unsigned char* ws = p.ws;
    constexpr int IT_WIN = 16 * 64, IT_WOUT = 16 * 32, IT_WQKV = 16 * 48, IT_WO = 16 * 32, IT_UP = 16 * 128, IT_DN = 64 * 32, IT_G = 32 * 8;
    constexpr int NIT = IT_WIN + IT_G;
    (void)IT_WOUT; (void)IT_WQKV; (void)IT_WO; (void)IT_UP; (void)IT_DN;
    for (int it = gw; it < NIT; it += ngw) {
        int r = it;
        if (r < IT_WIN) { transpose_item(p.in[I_WIN], DM, 2 * DM, (bf16_t*)(ws + WS_WIN), 0, scr, r, lane, p.in[I_GMIX]); continue; } r -= IT_WIN;
        {
            const int mi = r >> 3, sub = r & 7, ax = mi >> 4, d = (mi >> 3) & 1, h = mi & 7;
            const float* W = (ax ? p.in[I_WX] : p.in[I_WA]) + (size_t)(d * 8 + h) * 128 * 128;
            transpose_item(W, 128, 128, (bf16_t*)(ws + WS_WG) + (size_t)h * 512 * 128, (d * 2 + ax) * 128, scr, sub, lane);
        }
    }
    xb_rows(p.in[I_X], (bf16_t*)(ws + WS_HN), (float*)(ws + WS_PART), gw, ngw, lane);
}

constexpr int TL = 64, NCHK = SEQ / TL;
constexpr int A_PITCH = 272, H_PITCH = 132;
constexpr int L_A = 0, L_H = 17408, L_CW = L_H + 33792, L_RAW = L_CW + 2560;
static_assert(L_RAW + 68 * 256 <= LDS_MAIN, "lds");

template <bool REV>
__device__ __forceinline__ void lru_scan(f32x4 (&av)[4], f32x4 (&uv)[4], float& S, int fr, int fq) {
    const int fqe = REV ? 3 - fq : fq;
    const bool g1 = fqe >= 1, g2 = fqe >= 2, g3 = fqe >= 3;
    float Ak[4][4], Hk[4][4];
#pragma unroll
    for (int mi = 0; mi < 4; ++mi) {
        const int m = REV ? 3 - mi : mi;
        const f32x4 a = av[m], u = uv[m];
        float Hl, Al;
        if (!REV) { Hl = u[0]; Al = a[0]; Hl = a[1] * Hl + u[1]; Al *= a[1]; Hl = a[2] * Hl + u[2]; Al *= a[2]; Hl = a[3] * Hl + u[3]; Al *= a[3]; }
        else      { Hl = u[3]; Al = a[3]; Hl = a[2] * Hl + u[2]; Al *= a[2]; Hl = a[1] * Hl + u[1]; Al *= a[1]; Hl = a[0] * Hl + u[0]; Al *= a[0]; }
#pragma unroll
        for (int k = 0; k < 4; ++k) { const int src = fr + 16 * (REV ? 3 - k : k); Ak[mi][k] = __shfl(Al, src); Hk[mi][k] = __shfl(Hl, src); }
    }
#pragma unroll
    for (int mi = 0; mi < 4; ++mi) {
        const int m = REV ? 3 - mi : mi;
        const f32x4 a = av[m]; f32x4 u = uv[m];
        const float S0 = S, S1 = Ak[mi][0] * S0 + Hk[mi][0], S2 = Ak[mi][1] * S1 + Hk[mi][1], S3 = Ak[mi][2] * S2 + Hk[mi][2];
        S = Ak[mi][3] * S3 + Hk[mi][3];
        float prev = S0; prev = g1 ? S1 : prev; prev = g2 ? S2 : prev; prev = g3 ? S3 : prev;
        if (!REV) {
#pragma unroll
            for (int j = 0; j < 4; ++j) { prev = a[j] * prev + u[j]; u[j] = prev; }
        } else {
#pragma unroll
            for (int j = 3; j >= 0; --j) { prev = a[j] * prev + u[j]; u[j] = prev; }
        }
        uv[m] = u;
    }
}

#define XB_TMO      128
#define XB_XCNT(j)  (256  + 64 * (j))
#define XB_XSUB(j)  (1280 + 64 * (j))
#define XB_XGEN(j)  (2304 + 64 * (j))
#define XB_TOP      3328
#define XB_TOPGEN   3392
#define XCD_BAR_WORDS 3456
#define XB_SPIN_CAP (1u << 20)
__device__ __forceinline__ unsigned xb_ld(unsigned* p)              { return __hip_atomic_load(p, __ATOMIC_RELAXED, __HIP_MEMORY_SCOPE_AGENT); }
__device__ __forceinline__ unsigned xb_add(unsigned* p, unsigned v) { return __hip_atomic_fetch_add(p, v, __ATOMIC_RELAXED, __HIP_MEMORY_SCOPE_AGENT); }
__device__ __forceinline__ unsigned xb_xcc_id() { return (unsigned)__builtin_amdgcn_s_getreg((3 << 11) | 20) & 0xFu; }
#define XB_SPIN(cond, bar) do { unsigned _sp = 0; while (cond) { __builtin_amdgcn_s_sleep(1); \
    if ((++_sp & 255u) == 0u) { if (xb_ld(&(bar)[XB_TMO])) break; if (_sp > XB_SPIN_CAP) { atomicAdd(&(bar)[XB_TMO], 1u); break; } } } } while (0)
struct XcdBarrier { unsigned* bar; unsigned x; volatile LAS unsigned* st; };
__device__ __forceinline__ XcdBarrier xcd_barrier_post(unsigned* bar, volatile LAS unsigned* st) {
    XcdBarrier b; b.bar = bar; b.x = xb_xcc_id(); b.st = st;
    if (threadIdx.x == 0) (void)xb_add(&bar[XB_XCNT(b.x)], 1u);
    return b;
}
__device__ __forceinline__ void xcd_barrier_complete(unsigned* bar, unsigned x, unsigned& nloc, unsigned& nx) {
    const unsigned G = gridDim.x * gridDim.y * gridDim.z;
    unsigned sum, cnt, mine, sp = 0u;
    for (;;) {
        sum = 0u; cnt = 0u; mine = 0u;
#pragma nounroll
        for (unsigned j = 0; j < 16; ++j) { const unsigned c = xb_ld(&bar[XB_XCNT(j)]); sum += c; cnt += (c > 0u) ? 1u : 0u; mine = (j == x) ? c : mine; }
        if (sum == G) break;
        __builtin_amdgcn_s_sleep(1);
        if ((++sp & 255u) == 0u) { if (xb_ld(&bar[XB_TMO])) break; if (sp > XB_SPIN_CAP) { atomicAdd(&bar[XB_TMO], 1u); break; } }
    }
    nloc = mine > 0u ? mine : 1u; nx = cnt > 0u ? cnt : 1u;
}
__device__ __forceinline__ void xcd_barrier(const XcdBarrier& b, int wv) {
    asm volatile("s_waitcnt vmcnt(0)" ::: "memory");
    __syncthreads();
    unsigned* bar = b.bar; const unsigned bx = b.x;
    if (wv == 0 && __builtin_amdgcn_mbcnt_hi(~0u, __builtin_amdgcn_mbcnt_lo(~0u, 0u)) == 0u) {
        __builtin_amdgcn_s_waitcnt(0);
        unsigned nloc = b.st[0], nx = b.st[1];
        if (nloc == 0u) { xcd_barrier_complete(bar, bx, nloc, nx); b.st[0] = nloc; b.st[1] = nx; }
        const unsigned old = xb_add(&bar[XB_XSUB(bx)], 1u);
        const unsigned gen = old / nloc;
        if (old + 1u == (gen + 1u) * nloc) {
            __builtin_amdgcn_fence(__ATOMIC_RELEASE, "agent");
            asm volatile("s_waitcnt vmcnt(0)" ::: "memory");
            const unsigned og = xb_add(&bar[XB_TOP], 1u);
            const unsigned tg = og / nx;
            if (og + 1u == (tg + 1u) * nx) xb_add(&bar[XB_TOPGEN], 1u);
            else XB_SPIN(xb_ld(&bar[XB_TOPGEN]) == tg, bar);
            __builtin_amdgcn_fence(__ATOMIC_ACQUIRE, "agent");
            xb_add(&bar[XB_XGEN(bx)], 1u);
            asm volatile("s_waitcnt vmcnt(0)" ::: "memory");
        } else {
            XB_SPIN(xb_ld(&bar[XB_XGEN(bx)]) == gen, bar);
            __builtin_amdgcn_fence(__ATOMIC_ACQUIRE, "agent");
            asm volatile("s_waitcnt vmcnt(0)" ::: "memory");
        }
    }
    __syncthreads();
}

constexpr int WC_OUT = 0, WC_QKV = WC_OUT + (DM / 16) * (DM / 32), WC_O = WC_QKV + (DM / 16) * (NQKV / 32), WC_UP0 = WC_O + (DM / 16) * (DM / 32), WC_UP1 = WC_UP0 + (DM / 16) * (DFF / 32),
              WC_DN0 = WC_UP1 + (DM / 16) * (DFF / 32), WC_DN1 = WC_DN0 + (DFF / 16) * (DM / 32), WC_END = WC_DN1 + (DFF / 16) * (DM / 32);
struct WcItem { const float* src; bf16_t* dst; const float* gk; int N; };
template <int K, int N> __device__ __forceinline__ WcItem wconv_mk(const float* W, bf16_t* WT, const float* gk, int r, int lane) {
    constexpr int nblk = N / 32; const int k0 = (r / nblk) * 16 + (lane >> 5) * 8, n = (r % nblk) * 32 + (lane & 31);
    return WcItem{W + (size_t)k0 * N + n, WT + (size_t)n * K + k0, gk ? gk + k0 : nullptr, N};
}
__device__ __forceinline__ WcItem wconv_decode(const P& p, int idx, int lane) {
    unsigned char* ws = p.ws;
    if (idx < WC_QKV) return wconv_mk<DM, DM>(p.in[I_WOUT], (bf16_t*)(ws + WS_WOUT), nullptr, idx - WC_OUT, lane);
    if (idx < WC_O)   return wconv_mk<DM, NQKV>(p.in[I_WQKV], (bf16_t*)(ws + WS_WQKV), p.in[I_GMIX] + DM, idx - WC_QKV, lane);
    if (idx < WC_UP0) return wconv_mk<DM, DM>(p.in[I_WO], (bf16_t*)(ws + WS_WO), nullptr, idx - WC_O, lane);
    if (idx < WC_UP1) return wconv_mk<DM, DFF>(p.in[I_WUP], (bf16_t*)(ws + WS_WUP0), p.in[I_GMLP], idx - WC_UP0, lane);
    if (idx < WC_DN0) return wconv_mk<DM, DFF>(p.in[I_WUP] + (size_t)DM * DFF, (bf16_t*)(ws + WS_WUP1), p.in[I_GMLP] + DM, idx - WC_UP1, lane);
    if (idx < WC_DN1) return wconv_mk<DFF, DM>(p.in[I_WDN], (bf16_t*)(ws + WS_WDN0), nullptr, idx - WC_DN0, lane);
    return wconv_mk<DFF, DM>(p.in[I_WDN] + (size_t)DM * DFF, (bf16_t*)(ws + WS_WDN1), nullptr, idx - WC_DN1, lane);
}
__device__ __forceinline__ void wconv_load(const WcItem& t, float (&v)[8]) {
#pragma unroll
    for (int e = 0; e < 8; ++e) v[e] = t.src[(size_t)e * t.N];
}
__device__ __forceinline__ void wconv_store(const WcItem& t, const float (&v)[8]) {
    f32x4 g0 = (f32x4){1.f, 1.f, 1.f, 1.f}, g1 = g0; if (t.gk) { g0 = *(const f32x4*)(t.gk); g1 = *(const f32x4*)(t.gk + 4); }
    u32x4 o; o.x = pk2(v[0] * g0[0], v[1] * g0[1]); o.y = pk2(v[2] * g0[2], v[3] * g0[3]); o.z = pk2(v[4] * g1[0], v[5] * g1[1]); o.w = pk2(v[6] * g1[2], v[7] * g1[3]);
    *(u32x4*)t.dst = o;
}
__device__ __forceinline__ void lru_mid_barrier(unsigned char* ws, LAS unsigned char* lds, int wv) {
    unsigned char* w = ws; asm volatile("" : "+s"(w));
    XcdBarrier xb; xb.bar = (unsigned*)(w + WS_BAR); xb.x = xb_xcc_id(); xb.st = (volatile LAS unsigned*)(lds + LDS_MAIN);
    xcd_barrier(xb, wv);
}
__device__ __forceinline__ void lru_phase(const P& p, LAS unsigned char* lds, int wv) {
    const int tid = ltid(wv), wid = __builtin_amdgcn_readfirstlane(tid >> 6), lane = tid & 63, fr = lane & 15, fq = lane >> 4;
    const bf16_t* RECPRE = (const bf16_t*)(p.ws + WS_RECPRE);
    const bf16_t* WG = (const bf16_t*)(p.ws + WS_WG);
    const int cv = tid & 15, tp = tid >> 4, lt0 = 2 * tp;
    LAS float* cw = (LAS float*)(lds + L_CW);
    LAS float* hbuf = (LAS float*)(lds + L_H);
    const bf16_t* GATE = (const bf16_t*)(p.ws + WS_GATE);
    bf16_t* Y = (bf16_t*)(p.ws + WS_Y);
    const int G = gridDim.x, ngi = (256 + G - 1) / G;
    const int ngw = G * NWAVES; int widx = lbid() * NWAVES + wid;
    for (int gi = 0; gi < ngi; ++gi) {
        const int grp = lbid() + gi * G;
        if (grp >= 256) { lru_mid_barrier(p.ws, lds, wv); continue; }
        const int d = grp & 1, h = (grp >> 1) & 7, b = grp >> 4;
        bf16_t* HD = (bf16_t*)(p.ws + (d ? WS_HB : WS_HF));
        const bf16_t* HP = (const bf16_t*)(p.ws + (d ? WS_HF : WS_HB));
        bf16x8 bfr[2][4];
#pragma unroll
        for (int nn = 0; nn < 2; ++nn)
#pragma unroll
            for (int kk = 0; kk < 4; ++kk) { const int row = (d * 2 + nn) * 128 + wid * 16 + fr;
                bfr[nn][kk] = *(const bf16x8*)(WG + ((size_t)h * 512 + row) * 128 + kk * 32 + fq * 8); }
        const int chl = wid * 16 + fr, chg = d * DM + h * 128 + chl;
        const float nba = -1.4426950408889634f * p.in[I_BA][chg], nbx = -1.4426950408889634f * p.in[I_BX][chg], clu = -8.0f * log1pf(expf(-p.in[I_LAM][chg]));
        __syncthreads();
        for (int i = tid; i < 640; i += NTHREADS) { const int tap = i >> 7, ch = i & 127; cw[i] = tap < 4 ? p.in[I_CONVW][tap * DM + h * 128 + ch] : p.in[I_CONVB][h * 128 + ch]; }
#define LRU_DMA_ROWS(c) do { _Pragma("unroll") for (int qi = 0; qi < 3; ++qi) { const int qq = wid + 8 * qi; if (qq < 17) { \
            int t = (c) * TL + 4 * qq + (lane >> 4) - 2; t = t < 0 ? 0 : (t > SEQ - 1 ? SEQ - 1 : t); \
            __builtin_amdgcn_global_load_lds((const unsigned*)(RECPRE + ((size_t)(b * SEQ + t)) * DM + h * 128 + (lane & 15) * 8), (LAS unsigned*)(lds + L_RAW + qq * 1024), 16, 0, 0); } } } while (0)
        LRU_DMA_ROWS(d ? NCHK - 1 : 0);
        asm volatile("s_waitcnt vmcnt(0)" ::: "memory");
        __syncthreads();
        float S = 0.f;
        for (int ci = 0; ci < NCHK; ++ci) {
            const int c = d ? NCHK - 1 - ci : ci;
            if (ci == NCHK / 2) lru_mid_barrier(p.ws, lds, wv);
            const bool comb = ci >= NCHK / 2;
            float wcv[8]; const bool wc_on = widx < WC_END; WcItem wt{};
            if (wc_on) { wt = wconv_decode(p, widx, lane); wconv_load(wt, wcv); }
            u32x4 ph[2], gt[2];
            if (comb) {
#pragma unroll
                for (int tt = 0; tt < 2; ++tt) { const size_t o = ((size_t)(b * SEQ + c * TL + lt0 + tt)) * DM + h * 128 + cv * 8; ph[tt] = *(const u32x4*)(HP + o); gt[tt] = *(const u32x4*)(GATE + o); }
            }
            {
                u32x4 rw[5];
#pragma unroll
                for (int i = 0; i < 5; ++i) { const int t = c * TL + lt0 - 2 + i; const u32x4 v = *(const LAS u32x4*)(lds + L_RAW + (lt0 + i) * 256 + cv * 16);
                    rw[i] = (t >= 0 && t < SEQ) ? v : (u32x4){0u, 0u, 0u, 0u}; }
                f32x4 wv[5][2];
#pragma unroll
                for (int tap = 0; tap < 5; ++tap) { wv[tap][0] = *(const LAS f32x4*)(cw + tap * 128 + cv * 8); wv[tap][1] = *(const LAS f32x4*)(cw + tap * 128 + cv * 8 + 4); }
                u32x4 o0, o1;
#pragma unroll
                for (int e = 0; e < 4; ++e) {
                    f32x2 W[5], X[5];
#pragma unroll
                    for (int tap = 0; tap < 5; ++tap) W[tap] = (f32x2){wv[tap][e >> 1][(2 * e) & 3], wv[tap][e >> 1][(2 * e + 1) & 3]};
#pragma unroll
                    for (int i = 0; i < 5; ++i) X[i] = (f32x2){bflo(rw[i][e]), bfhi(rw[i][e])};
                    f32x2 a0 = W[4], a1 = W[4];
                    a0 = W[0] * X[0] + a0; a0 = W[1] * X[1] + a0; a0 = W[2] * X[2] + a0; a0 = W[3] * X[3] + a0;
                    a1 = W[0] * X[1] + a1; a1 = W[1] * X[2] + a1; a1 = W[2] * X[3] + a1; a1 = W[3] * X[4] + a1;
                    o0[e] = pk2(a0.x, a0.y); o1[e] = pk2(a1.x, a1.y);
                }
                *(LAS u32x4*)(lds + L_A + lt0 * A_PITCH + cv * 16) = o0;
                *(LAS u32x4*)(lds + L_A + (lt0 + 1) * A_PITCH + cv * 16) = o1;
            }
            __syncthreads();
            if (ci + 1 < NCHK) LRU_DMA_ROWS(d ? c - 1 : c + 1);
            f32x4 av[4], uv[4];
#pragma unroll
            for (int m = 0; m < 4; ++m) { av[m] = (f32x4){0.f, 0.f, 0.f, 0.f}; uv[m] = (f32x4){0.f, 0.f, 0.f, 0.f}; }
#pragma unroll
            for (int m = 0; m < 4; ++m)
#pragma unroll
                for (int kk = 0; kk < 4; ++kk) {
                    const bf16x8 a = *(const LAS bf16x8*)(lds + L_A + (m * 16 + fr) * A_PITCH + (kk * 32 + fq * 8) * 2);
                    av[m] = __builtin_amdgcn_mfma_f32_16x16x32_bf16(a, bfr[0][kk], av[m], 0, 0, 0);
                    uv[m] = __builtin_amdgcn_mfma_f32_16x16x32_bf16(a, bfr[1][kk], uv[m], 0, 0, 0);
                }
#pragma unroll
            for (int m = 0; m < 4; ++m)
#pragma unroll
                for (int jp = 0; jp < 4; jp += 2) {
                    const int tok = m * 16 + fq * 4 + jp;
                    f32x2 x;
                    x.x = __uint_as_float((unsigned)(*(const LAS unsigned short*)(lds + L_A + tok * A_PITCH + chl * 2)) << 16);
                    x.y = __uint_as_float((unsigned)(*(const LAS unsigned short*)(lds + L_A + (tok + 1) * A_PITCH + chl * 2)) << 16);
                    const f32x2 zr = {av[m][jp], av[m][jp + 1]}, zi = {uv[m][jp], uv[m][jp + 1]};
                    f32x2 ar = zr * (-1.4426950408889634f) + nba, ai_ = zi * (-1.4426950408889634f) + nbx;
                    ar = __builtin_elementwise_min(ar, (f32x2){80.f, 80.f}); ai_ = __builtin_elementwise_min(ai_, (f32x2){80.f, 80.f});
                    f32x2 e1, e2; e1.x = __builtin_amdgcn_exp2f(ar.x); e1.y = __builtin_amdgcn_exp2f(ar.y); e2.x = __builtin_amdgcn_exp2f(ai_.x); e2.y = __builtin_amdgcn_exp2f(ai_.y);
                    const f32x2 d1 = e1 + 1.f, d2 = e2 + 1.f, pr = d1 * d2;
                    f32x2 R; R.x = __builtin_amdgcn_rcpf(pr.x); R.y = __builtin_amdgcn_rcpf(pr.y);
                    const f32x2 r = R * d2, ig = R * d1;
                    const f32x2 la = r * clu;
                    f32x2 pq = la * 0.0001984127f + 0.0013888889f; pq = pq * la + 0.0083333338f; pq = pq * la + 0.041666668f; pq = pq * la + 0.16666667f; pq = pq * la + 0.5f; pq = pq * la + 1.f;
                    const f32x2 q = -(la * pq);
                    const f32x2 s2 = q * (2.f - q);
                    f32x2 mult; mult.x = __builtin_amdgcn_sqrtf(fmaxf(s2.x, 0.f)); mult.y = __builtin_amdgcn_sqrtf(fmaxf(s2.y, 0.f));
                    const f32x2 an = 1.f - q, un = mult * (ig * x);
                    av[m][jp] = an.x; av[m][jp + 1] = an.y; uv[m][jp] = un.x; uv[m][jp + 1] = un.y;
                }
            if (d == 0) lru_scan<false>(av, uv, S, fr, fq); else lru_scan<true>(av, uv, S, fr, fq);
#pragma unroll
            for (int m = 0; m < 4; ++m)
#pragma unroll
                for (int j = 0; j < 4; ++j) hbuf[(m * 16 + fq * 4 + j) * H_PITCH + chl] = uv[m][j];
            asm volatile("s_waitcnt vmcnt(0)" ::: "memory");
            __syncthreads();
#pragma unroll
            for (int tt = 0; tt < 2; ++tt) {
                const LAS float* hp = hbuf + (lt0 + tt) * H_PITCH + cv * 8;
                const f32x4 f0 = *(const LAS f32x4*)hp, f1 = *(const LAS f32x4*)(hp + 4);
                u32x4 w; const size_t o = ((size_t)(b * SEQ + c * TL + lt0 + tt)) * DM + h * 128 + cv * 8;
                if (!comb) { w.x = pk2(f0[0], f0[1]); w.y = pk2(f0[2], f0[3]); w.z = pk2(f1[0], f1[1]); w.w = pk2(f1[2], f1[3]); *(u32x4*)(HD + o) = w; }
                else {
                    const u32x4 q = ph[tt], g = gt[tt];
                    w.x = pk2((f0[0] + bflo(q.x)) * bflo(g.x), (f0[1] + bfhi(q.x)) * bfhi(g.x)); w.y = pk2((f0[2] + bflo(q.y)) * bflo(g.y), (f0[3] + bfhi(q.y)) * bfhi(g.y));
                    w.z = pk2((f1[0] + bflo(q.z)) * bflo(g.z), (f1[1] + bfhi(q.z)) * bfhi(g.z)); w.w = pk2((f1[2] + bflo(q.w)) * bflo(g.w), (f1[3] + bfhi(q.w)) * bfhi(g.w));
                    *(u32x4*)(Y + o) = w; }
            }
            if (wc_on) { wconv_store(wt, wcv); widx += ngw;
            }
        }
#undef LRU_DMA_ROWS
    }
    for (; widx < WC_END; widx += ngw) { const WcItem wt2 = wconv_decode(p, widx, lane); float v[8]; wconv_load(wt2, v); wconv_store(wt2, v); }
}
__device__ __forceinline__ void ycomb_phase(const P& p, int wv) {
    const u32x4* HF = (const u32x4*)(p.ws + WS_HF); const u32x4* HB = (const u32x4*)(p.ws + WS_HB); const u32x4* GT = (const u32x4*)(p.ws + WS_GATE);
    u32x4* Y = (u32x4*)(p.ws + WS_Y);
    const size_t n = (size_t)MTOK * DM / 8, stride = (size_t)gridDim.x * NTHREADS;
    for (size_t i = (size_t)lbid() * NTHREADS + ltid(wv); i < n; i += 4 * stride) {
        u32x4 f[4], k[4], g[4];
#pragma unroll
        for (int u = 0; u < 4; ++u) { const size_t ii = i + u * stride; if (ii < n) { f[u] = HF[ii]; k[u] = HB[ii]; g[u] = GT[ii]; } }
#pragma unroll
        for (int u = 0; u < 4; ++u) { const size_t ii = i + u * stride; if (ii < n) { u32x4 w;
#pragma unroll
            for (int e = 0; e < 4; ++e) w[e] = pk2((bflo(f[u][e]) + bflo(k[u][e])) * bflo(g[u][e]), (bfhi(f[u][e]) + bfhi(k[u][e])) * bfhi(g[u][e]));
            Y[ii] = w; } }
    }
}

__device__ __forceinline__ u32x4 rope_chunk(u32x4 w, const float (&g)[8], const float (&cs)[8], const float (&sn)[8]) {
    float v[8] = {bflo(w.x), bfhi(w.x), bflo(w.y), bfhi(w.y), bflo(w.z), bfhi(w.z), bflo(w.w), bfhi(w.w)};
    float ss = 0.f;
#pragma unroll
    for (int e = 0; e < 8; ++e) ss += v[e] * v[e];
    ss += lane_xor<1>(ss); ss += lane_xor<2>(ss); ss += lane_xor<4>(ss); ss += lane_xor<8>(ss);
    const float rs = rsqrtf(ss * (1.f / 128.f) + EPS);
    float o[8];
#pragma unroll
    for (int e = 0; e < 8; ++e) { const float y = v[e] * rs * g[e]; const float py = lane_xor<4>(y); o[e] = y * cs[e] + py * sn[e]; }
    u32x4 r; r.x = pk2(o[0], o[1]); r.y = pk2(o[2], o[3]); r.z = pk2(o[4], o[5]); r.w = pk2(o[6], o[7]);
    return r;
}
__device__ __forceinline__ void rope_phase(const P& p, int wave, int lane, bool dry) {
    bf16_t* Q = (bf16_t*)(p.ws + WS_Q); bf16_t* Kb = (bf16_t*)(p.ws + WS_K);
    bf16_t* Qo = dry ? (bf16_t*)(p.ws + WS_HB) : Q; bf16_t* Ko = dry ? (bf16_t*)(p.ws + WS_HB) : Kb;
    const int gw = lbid() * NWAVES + wave, ngw = gridDim.x * NWAVES;
    const int j = lane & 15, hs = lane >> 4;
    float gq[8], gk[8], inv[8];
#pragma unroll
    for (int e = 0; e < 8; ++e) { gq[e] = p.in[I_QG][8 * j + e]; gk[e] = p.in[I_KG][8 * j + e]; inv[e] = exp2f(-(float)(8 * (j & 3) + e) * (13.287712379549449f / 32.f)) * 0.15915494309189535f; }
    const float sgn = (j & 4) ? 1.f : -1.f;
    for (int tk = 2 * gw; tk < MTOK; tk += 2 * ngw) {
        u32x4 qa[2], qb[2], kk[2];
#pragma unroll
        for (int u = 0; u < 2; ++u) { const size_t tok = tk + u;
            qa[u] = *(const u32x4*)(Q + tok * DM + hs * 128 + j * 8); qb[u] = *(const u32x4*)(Q + tok * DM + 512 + hs * 128 + j * 8);
            kk[u] = *(const u32x4*)(Kb + tok * NKV + (hs & 1) * 128 + j * 8); }
#pragma unroll
        for (int u = 0; u < 2; ++u) { const size_t tok = tk + u; const int t = (int)tok & (SEQ - 1);
            const float pos = (float)(j < 8 ? (t >> 6) : (t & 63));
            float cs[8], sn[8];
#pragma unroll
            for (int e = 0; e < 8; ++e) { const float a = pos * inv[e]; cs[e] = __builtin_amdgcn_cosf(a); sn[e] = sgn * __builtin_amdgcn_sinf(a); }
            const u32x4 ra = rope_chunk(qa[u], gq, cs, sn), rb = rope_chunk(qb[u], gq, cs, sn), rk = rope_chunk(kk[u], gk, cs, sn);
            *(u32x4*)(Qo + tok * DM + hs * 128 + j * 8) = ra; *(u32x4*)(Qo + tok * DM + 512 + hs * 128 + j * 8) = rb;
            if (hs < 2) *(u32x4*)(Ko + tok * NKV + hs * 128 + j * 8) = rk; }
    }
}

__device__ __forceinline__ void rope_tile(bf16_t* base, int ld, int tok0, const float* g, int wave, int lane) {
    const int j = lane & 15, hs = lane >> 4, rr = hs >> 1, hh = hs & 1;
    float g8[8], inv[8];
#pragma unroll
    for (int e = 0; e < 8; ++e) { g8[e] = g[8 * j + e]; inv[e] = exp2f(-(float)(8 * (j & 3) + e) * (13.287712379549449f / 32.f)) * 0.15915494309189535f; }
    const float sgn = (j & 4) ? 1.f : -1.f;
    for (int it = 0; it < 16; it += 8) {
        u32x4 w[8];
#pragma unroll
        for (int u = 0; u < 8; ++u) { const int r = wave * 32 + (it + u) * 2 + rr; w[u] = *(const u32x4*)(base + (size_t)r * ld + hh * 128 + j * 8); }
#pragma unroll
        for (int u = 0; u < 8; ++u) { const int r = wave * 32 + (it + u) * 2 + rr; const int t = (tok0 + r) & (SEQ - 1);
            const float pos = (float)(j < 8 ? (t >> 6) : (t & 63));
            float cs[8], sn[8];
#pragma unroll
            for (int e = 0; e < 8; ++e) { const float a = pos * inv[e]; cs[e] = __builtin_amdgcn_cosf(a); sn[e] = sgn * __builtin_amdgcn_sinf(a); }
            *(u32x4*)(base + (size_t)r * ld + hh * 128 + j * 8) = rope_chunk(w[u], g8, cs, sn); }
    }
}

namespace attn {
constexpr int D = 128, NW = 8, QBLK = 32, KVBLK = 64;
constexpr float SCALE = 0.088388347648318440f;
constexpr float THR = 8.f;
constexpr int LDQ = DM, LDK = NKV, LDO = DM;
constexpr size_t SHM_V = KVBLK * D * 2, SHM_K = KVBLK * D * 2, SHM_ATTN = 2 * SHM_V + 2 * SHM_K + NW * 64 * 4;
#define KSWZ(row, colB) ((row) * 256 + ((colB) ^ (((row) & 7) << 4)))
#define SBAR() __builtin_amdgcn_sched_barrier(0)
__device__ __forceinline__ int crow(int r, int hi) { return (r & 3) + 8 * (r >> 2) + 4 * hi; }
__device__ __forceinline__ unsigned cvtpk(float lo, float hi) { unsigned r; asm volatile("v_cvt_pk_bf16_f32 %0, %1, %2" : "=v"(r) : "v"(lo), "v"(hi)); return r; }
__device__ __forceinline__ void partialSM(f32x16& p0, f32x16& p1, float& m_reg, float& mn, float& alpha) {
    constexpr float C = SCALE * 1.4426950408889634f;
    float pmax = p0[0]; for (int r = 1; r < 16; ++r) pmax = fmaxf(pmax, p0[r]); for (int r = 0; r < 16; ++r) pmax = fmaxf(pmax, p1[r]);
    { auto rr = __builtin_amdgcn_permlane32_swap(__float_as_uint(pmax), __float_as_uint(pmax), false, false);
      pmax = fmaxf(__uint_as_float(rr[0]), __uint_as_float(rr[1])); }
    if (__builtin_expect(__all(pmax - m_reg <= THR / SCALE), 1)) { mn = m_reg; alpha = 1.f; }
    else { mn = fmaxf(m_reg, pmax); alpha = __builtin_amdgcn_exp2f((m_reg - mn) * C); m_reg = mn; }
    float mnC = -mn * C;
    for (int r = 0; r < 16; ++r) p0[r] = fmaf(p0[r], C, mnC); for (int r = 0; r < 16; ++r) p1[r] = fmaf(p1[r], C, mnC);
    for (int r = 0; r < 16; ++r) p0[r] = __builtin_amdgcn_exp2f(p0[r]);
}
__device__ __forceinline__ void finishSM(f32x16& p0, f32x16& p1, float alpha, float& l_reg, bf16x8& pa0, bf16x8& pa1, bf16x8& pa2, bf16x8& pa3) {
    for (int r = 0; r < 16; ++r) p1[r] = __builtin_amdgcn_exp2f(p1[r]);
    float ps = 0; for (int r = 0; r < 16; ++r) ps += p0[r]; for (int r = 0; r < 16; ++r) ps += p1[r];
    { auto rr = __builtin_amdgcn_permlane32_swap(__float_as_uint(ps), __float_as_uint(ps), false, false);
      ps = __uint_as_float(rr[0]) + __uint_as_float(rr[1]); }
    l_reg = l_reg * alpha + ps;
#define PK4(P, BASE, OUT) do { unsigned a0 = cvtpk(P[BASE + 0], P[BASE + 1]), a1 = cvtpk(P[BASE + 2], P[BASE + 3]);   \
    unsigned b0 = cvtpk(P[BASE + 4], P[BASE + 5]), b1 = cvtpk(P[BASE + 6], P[BASE + 7]);                              \
    auto r0 = __builtin_amdgcn_permlane32_swap(a0, b0, false, false); auto r1 = __builtin_amdgcn_permlane32_swap(a1, b1, false, false); \
    u32x4 w = {r0[0], r1[0], r0[1], r1[1]}; OUT = *reinterpret_cast<bf16x8*>(&w); } while (0)
    PK4(p0, 0, pa0); PK4(p0, 8, pa1); PK4(p1, 0, pa2); PK4(p1, 8, pa3);
#undef PK4
}
__device__ __forceinline__ void qkt(f32x16& p0, f32x16& p1, const bf16_t* Ks, const bf16x8* qr, int r32, int hi) {
    p0 = f32x16{}; p1 = f32x16{};
    for (int d0 = 0; d0 < 8; ++d0) { int cb = (d0 * 16 + hi * 8) * 2;
        bf16x8 b0 = *reinterpret_cast<const bf16x8*>((const char*)Ks + KSWZ(r32, cb));
        bf16x8 b1 = *reinterpret_cast<const bf16x8*>((const char*)Ks + KSWZ(32 + r32, cb));
        p0 = __builtin_amdgcn_mfma_f32_32x32x16_bf16(b0, qr[d0], p0, 0, 0, 0);
        p1 = __builtin_amdgcn_mfma_f32_32x32x16_bf16(b1, qr[d0], p1, 0, 0, 0); }
}
__device__ __forceinline__ int v_st(int k, int c) { const int kk = (k & ~0xC) | ((k & 4) << 1) | ((k & 8) >> 1); return ((kk >> 3) * 4 + (c >> 5)) * 512 + ((kk & 7) * 32 + (c & 31)) * 2; }
__device__ __forceinline__ int v_rd_base(int lane) { return ((lane & 3) << 3) | (((lane >> 2) & 3) << 6) | (((lane >> 4) & 1) << 5) | (((lane >> 5) & 1) << 8); }
constexpr int v_rd_off(int d0, int ks, int half) { return d0 * 512 + ks * 4096 + half * 2048; }
template <int OFF> __device__ __forceinline__ s16x4 tr_read(int vb) {
    s16x4 r; asm volatile("ds_read_b64_tr_b16 %0, %1 offset:%2" : "=&v"(r) : "v"(vb), "i"(OFF) : "memory"); return r;
}
template <int D0> __device__ __forceinline__ void pv_one(f32x16& od, int vb, bf16x8 pa0, bf16x8 pa1, bf16x8 pa2, bf16x8 pa3) {
    const s16x4 l0 = tr_read<v_rd_off(D0, 0, 0)>(vb), h0 = tr_read<v_rd_off(D0, 0, 1)>(vb), l1 = tr_read<v_rd_off(D0, 1, 0)>(vb), h1 = tr_read<v_rd_off(D0, 1, 1)>(vb);
    const s16x4 l2 = tr_read<v_rd_off(D0, 2, 0)>(vb), h2 = tr_read<v_rd_off(D0, 2, 1)>(vb), l3 = tr_read<v_rd_off(D0, 3, 0)>(vb), h3 = tr_read<v_rd_off(D0, 3, 1)>(vb);
    asm volatile("s_waitcnt lgkmcnt(0)" ::: "memory"); SBAR();
#define PK(L, H) (bf16x8){L[0], L[1], L[2], L[3], H[0], H[1], H[2], H[3]}
    od = __builtin_amdgcn_mfma_f32_32x32x16_bf16(pa0, PK(l0, h0), od, 0, 0, 0);
    od = __builtin_amdgcn_mfma_f32_32x32x16_bf16(pa1, PK(l1, h1), od, 0, 0, 0);
    od = __builtin_amdgcn_mfma_f32_32x32x16_bf16(pa2, PK(l2, h2), od, 0, 0, 0);
    od = __builtin_amdgcn_mfma_f32_32x32x16_bf16(pa3, PK(l3, h3), od, 0, 0, 0);
#undef PK
}
__device__ __forceinline__ void pv_d0(f32x16* o, int vb, bf16x8 pa0, bf16x8 pa1, bf16x8 pa2, bf16x8 pa3) {
    pv_one<0>(o[0], vb, pa0, pa1, pa2, pa3); pv_one<1>(o[1], vb, pa0, pa1, pa2, pa3); pv_one<2>(o[2], vb, pa0, pa1, pa2, pa3); pv_one<3>(o[3], vb, pa0, pa1, pa2, pa3);
}
__device__ __forceinline__ void attn_dense_body(const bf16_t* Qb, const bf16_t* __restrict__ Kh, const bf16_t* __restrict__ Vh,
                                                bf16_t* Ob, int seq, char* lds, int wv, const float* qg, int t0) {
    const int tid = ltid(wv), wid = tid >> 6, lane = tid & 63, r32 = lane & 31, hi = lane >> 5;
    bf16_t* V_lds = (bf16_t*)lds; bf16_t* K_lds = (bf16_t*)(lds + 2 * SHM_V);
    float* ws = (float*)(lds + 2 * SHM_V + 2 * SHM_K) + wid * 64; float* li_l = ws; float* al_l = ws + 32;
    float m_reg = -1e30f, l_reg = 0; f32x16 o[4] = {}; bf16x8 qr[8];
    const bf16_t* Qw = Qb + (long)(wid * QBLK + r32) * LDQ + hi * 8;
#pragma unroll
    for (int d0 = 0; d0 < 8; ++d0) qr[d0] = *reinterpret_cast<const bf16x8*>(Qw + d0 * 16);
    {
        float ss = 0.f;
#pragma unroll
        for (int d0 = 0; d0 < 8; ++d0) { const u32x4 w = *reinterpret_cast<const u32x4*>(&qr[d0]);
#pragma unroll
            for (int e = 0; e < 4; ++e) { const float lo = bflo(w[e]), hi_ = bfhi(w[e]); ss += lo * lo + hi_ * hi_; } }
        ss = sum_xor32(ss);
        const float rs = rsqrtf(ss * (1.f / 128.f) + EPS);
        const int t = t0 + wid * QBLK + r32;
#pragma unroll
        for (int a = 0; a < 2; ++a) {
            const float pos = (float)(a ? (t & 63) : (t >> 6));
#pragma unroll
            for (int j = 0; j < 2; ++j) {
                const int c1 = 4 * a + j, c2 = c1 + 2;
                const u32x4 w1 = *reinterpret_cast<const u32x4*>(&qr[c1]), w2 = *reinterpret_cast<const u32x4*>(&qr[c2]);
                const f32x4 g1a = *(const f32x4*)(qg + c1 * 16 + hi * 8), g1b = *(const f32x4*)(qg + c1 * 16 + hi * 8 + 4), g2a = *(const f32x4*)(qg + c2 * 16 + hi * 8), g2b = *(const f32x4*)(qg + c2 * 16 + hi * 8 + 4);
                float o1[8], o2[8];
#pragma unroll
                for (int e = 0; e < 8; ++e) {
                    const float x1 = (e & 1) ? bfhi(w1[e >> 1]) : bflo(w1[e >> 1]), x2 = (e & 1) ? bfhi(w2[e >> 1]) : bflo(w2[e >> 1]);
                    const float g1 = e < 4 ? g1a[e & 3] : g1b[e & 3], g2 = e < 4 ? g2a[e & 3] : g2b[e & 3];
                    const float ang = pos * (exp2f(-(float)(j * 16 + hi * 8 + e) * (13.287712379549449f / 32.f)) * 0.15915494309189535f);
                    const float cs = __builtin_amdgcn_cosf(ang), sn = __builtin_amdgcn_sinf(ang);
                    const float y1 = x1 * rs * g1, y2 = x2 * rs * g2;
                    o1[e] = y1 * cs - y2 * sn; o2[e] = y2 * cs + y1 * sn;
                }
                u32x4 p1, p2;
#pragma unroll
                for (int e = 0; e < 4; ++e) { p1[e] = cvtpk(o1[2 * e], o1[2 * e + 1]); p2[e] = cvtpk(o2[2 * e], o2[2 * e + 1]); }
                qr[c1] = *reinterpret_cast<const bf16x8*>(&p1); qr[c2] = *reinterpret_cast<const bf16x8*>(&p2);
            }
        }
    }
    const int sr = tid >> 4, sc = (tid & 15) * 8, vst0 = v_st(sr, sc), vst1 = v_st(32 + sr, sc);
    const int vb0 = (int)(uintptr_t)V_lds + v_rd_base(lane);
    struct { bf16x8 vs0, vs1, ks0, ks1; } sr_[2];
#define LD8(p) (*reinterpret_cast<const bf16x8*>(p))
#define SLOAD(i, k0) do { sr_[i].vs0 = LD8(&Vh[(long)((k0) + sr) * LDK + sc]); sr_[i].vs1 = LD8(&Vh[(long)((k0) + 32 + sr) * LDK + sc]); \
    sr_[i].ks0 = LD8(&Kh[(long)((k0) + sr) * LDK + sc]); sr_[i].ks1 = LD8(&Kh[(long)((k0) + 32 + sr) * LDK + sc]); } while (0)
#define SWRITE(b, i) do { *(bf16x8*)((char*)V_lds + (b) * SHM_V + vst0) = sr_[i].vs0;          \
    *(bf16x8*)((char*)V_lds + (b) * SHM_V + vst1) = sr_[i].vs1; int kc = sc * 2;               \
    *(bf16x8*)((char*)K_lds + (b) * SHM_K + KSWZ(sr, kc)) = sr_[i].ks0;                       \
    *(bf16x8*)((char*)K_lds + (b) * SHM_K + KSWZ(32 + sr, kc)) = sr_[i].ks1; } while (0)
#define SWAIT() asm volatile("s_waitcnt vmcnt(4)" ::: "memory")
#define RESC(a) do { if (__any((a) < 1.f)) { if (hi == 0) al_l[r32] = (a); asm volatile("s_waitcnt lgkmcnt(0)" ::: "memory"); \
    for (int d = 0; d < 4; ++d) for (int r = 0; r < 16; ++r) o[d][r] *= al_l[crow(r, hi)]; } } while (0)
    f32x16 pA0, pA1, pB0, pB1; float mnA, mnB, alA, alB; bf16x8 pa0, pa1, pa2, pa3; const int NT = seq / KVBLK;
    constexpr int SE = 0, SO = 1;
    SLOAD(SE, 0); asm volatile("s_waitcnt vmcnt(0)" ::: "memory"); SWRITE(0, SE); __syncthreads();
    qkt(pA0, pA1, K_lds, qr, r32, hi); partialSM(pA0, pA1, m_reg, mnA, alA);
    SLOAD(SO, KVBLK); if (2 < NT) SLOAD(SE, 2 * KVBLK);
    SWAIT(); SWRITE(1, SO); __syncthreads();
    for (int j = 1; j + 1 < NT; j += 2) {
        SBAR(); qkt(pB0, pB1, (bf16_t*)((char*)K_lds + SHM_K), qr, r32, hi);
        finishSM(pA0, pA1, alA, l_reg, pa0, pa1, pa2, pa3); SBAR();
        SLOAD(SO, (j + 2) * KVBLK); SBAR();
        pv_d0(o, vb0, pa0, pa1, pa2, pa3); partialSM(pB0, pB1, m_reg, mnB, alB);
        __syncthreads(); SWAIT(); SWRITE(0, SE);
        RESC(alB); __syncthreads();
        SBAR(); qkt(pA0, pA1, K_lds, qr, r32, hi);
        finishSM(pB0, pB1, alB, l_reg, pa0, pa1, pa2, pa3); SBAR();
        if (j + 3 < NT) SLOAD(SE, (j + 3) * KVBLK); SBAR();
        pv_d0(o, vb0 + (int)SHM_V, pa0, pa1, pa2, pa3); partialSM(pA0, pA1, m_reg, mnA, alA);
        __syncthreads(); SWAIT(); SWRITE(1, SO);
        RESC(alA); __syncthreads();
    }
    SBAR(); qkt(pB0, pB1, (bf16_t*)((char*)K_lds + SHM_K), qr, r32, hi);
    finishSM(pA0, pA1, alA, l_reg, pa0, pa1, pa2, pa3); SBAR();
    pv_d0(o, vb0, pa0, pa1, pa2, pa3); partialSM(pB0, pB1, m_reg, mnB, alB);
    __syncthreads(); RESC(alB);
    finishSM(pB0, pB1, alB, l_reg, pa0, pa1, pa2, pa3); SBAR();
    pv_d0(o, vb0 + (int)SHM_V, pa0, pa1, pa2, pa3);
    if (hi == 0) li_l[r32] = l_reg; asm volatile("s_waitcnt lgkmcnt(0)" ::: "memory");
    float rli[16];
#pragma unroll
    for (int r = 0; r < 16; ++r) rli[r] = __builtin_amdgcn_rcpf(li_l[crow(r, hi)]);
    bf16_t* Ow = Ob + (long)(wid * QBLK) * LDO;
    const int odd = lane & 1;
#pragma unroll
    for (int r = 0; r < 16; r += 2) {
#pragma unroll
        for (int d0 = 0; d0 < 4; ++d0) {
            const float m0 = o[d0][r] * rli[r], m1 = o[d0][r + 1] * rli[r + 1];
            const float snd = odd ? m0 : m1;
            const float rcv = lane_xor<1>(snd);
            const unsigned w = odd ? cvtpk(rcv, m1) : cvtpk(m0, rcv);
            const int orow = crow(odd ? r + 1 : r, hi);
            *(unsigned*)(Ow + (long)orow * LDO + d0 * 32 + (r32 & ~1)) = w;
        }
    }
#undef LD8
#undef SLOAD
#undef SWRITE
#undef SWAIT
#undef RESC
}
}

__device__ __forceinline__ void attn_phase(const P& p, char* lds, bool dry, int wv) {
    const bf16_t* Q = (const bf16_t*)(p.ws + WS_Q); const bf16_t* Kb = (const bf16_t*)(p.ws + WS_K); const bf16_t* Vb = (const bf16_t*)(p.ws + WS_V);
    bf16_t* O = (bf16_t*)(p.ws + (dry ? WS_HB : WS_Q));
    const int G = gridDim.x, bx = lbid();
    const int vcu = (G % 8 == 0) ? (bx % 8) * (G / 8) + bx / 8 : bx;
    for (int it = vcu; it < BATCH * 8 * 8; it += G) {
        const int grp = it >> 5, within = it & 31, b = grp >> 1, kvh = grp & 1, h = kvh * 4 + (within >> 3), qb = within & 7;
        __syncthreads();
        attn::attn_dense_body(Q + ((size_t)(b * SEQ + qb * 256)) * DM + h * 128, Kb + (size_t)b * SEQ * NKV + kvh * 128, Vb + (size_t)b * SEQ * NKV + kvh * 128,
                              O + ((size_t)(b * SEQ + qb * 256)) * DM + h * 128, SEQ, lds, wv, p.in[I_QG], qb * 256);
    }
    __syncthreads();
}

constexpr int NPHASE = 14;
#ifndef ONLY
#define ONLY -1
#endif
#ifndef ENMASK
#define ENMASK 0x3fff
#endif
#ifndef REPMASK
#define REPMASK 0
#endif
#define EN(k) ((ONLY < 0 || ONLY == (k)) && ((ENMASK >> (k)) & 1))
typedef const __attribute__((address_space(4))) P* KP;
__device__ __forceinline__ P load_params() {
#if defined(__HIP_DEVICE_COMPILE__)
    KP kp = (KP)__builtin_amdgcn_kernarg_segment_ptr();
    asm volatile("" : "+s"(kp));
    return *kp;
#else
    return P{};
#endif
}
__global__ void __launch_bounds__(NTHREADS) mega(P parg) {
    extern __shared__ __attribute__((aligned(16))) unsigned char shm[];
    LAS unsigned char* lds = (LAS unsigned char*)shm;
    cg::grid_group grid = cg::this_grid();
    const int ph_lo = parg.ph_lo, ph_hi = parg.ph_hi;
    const int wv0 = __builtin_amdgcn_readfirstlane((int)threadIdx.x >> 6);
    if (ph_hi - ph_lo > 1) {
        volatile LAS unsigned* st = (volatile LAS unsigned*)(lds + LDS_MAIN);
        if (threadIdx.x == 0) { st[0] = 0u; st[1] = 0u; }
        __syncthreads();
        (void)xcd_barrier_post((unsigned*)(load_params().ws + WS_BAR), st);
    }
    int nseam = 0;
    for (int ph2 = 2 * ph_lo; ph2 < 2 * ph_hi; ++ph2) {
        const int ph = ph2 >> 1; const bool dry = (ph2 & 1);
        if (ph == 8 || ph == 3) continue;
        if ((ph2 & 1) && !((REPMASK >> ph) & 1)) continue;
#define WL() const int tid = ltid(wv0), wave = __builtin_amdgcn_readfirstlane(tid >> 6), lane = tid & 63; (void)lane; (void)wave
#define GW() const int gw = lbid() * NWAVES + wave, ngw = gridDim.x * NWAVES
        switch (ph) {
        case 0: if (EN(0)) { const P p = load_params(); WL(); prep_phase(p, lds, wave, lane); } break;
        case 1: if (EN(1)) { const P p = load_params(); unsigned char* ws = p.ws;
                  pg8::Gemm g{(const bf16_t*)(ws + WS_HN), (const bf16_t*)(ws + WS_WIN), MTOK, 2 * DM, DM}; pg8::StaticOrder S; S.init(MTOK, 2 * DM, gridDim.x, lbid());
                  pg8::EpiWin E{(bf16_t*)(ws + WS_GATE), (bf16_t*)(ws + WS_RECPRE), (const float*)(ws + WS_PART)}; pg8::gemm_phase(lds, g, S, E, wv0); } break;
        case 2: if (EN(2)) { const P p = load_params(); lru_phase(p, lds, wv0); } break;
        case 3: if (EN(3)) { const P p = load_params(); ycomb_phase(p, wv0); } break;
        case 4: case 6: case 10: case 12: if (EN(4)) {
            const P p = load_params(); unsigned char* ws = p.ws;
            const bf16_t* A = (const bf16_t*)(ws + (ph == 4 ? WS_Y : (ph == 10 ? WS_Q : WS_U)));
            const bf16_t* Bt = (const bf16_t*)(ws + (ph == 4 ? WS_WOUT : ph == 6 ? WS_WDN0 : ph == 10 ? WS_WO : WS_WDN1));
            const int K = (ph == 6 || ph == 12) ? DFF : DM;
            pg8::Gemm g{A, Bt, MTOK, DM, K}; pg8::StaticOrder S; S.init(MTOK, DM, gridDim.x, lbid());
            pg8::EpiResid E{(bf16_t*)(ws + (dry ? WS_HB : WS_HN)), (float*)(ws + (dry ? WS_HB : WS_PART)), ph != 12}; pg8::gemm_phase(lds, g, S, E, wv0); } break;
        case 5: case 11: if (EN(5)) {
            const P p = load_params(); unsigned char* ws = p.ws;
            pg8::Gemm g{(const bf16_t*)(ws + WS_HN), (const bf16_t*)(ws + (ph == 5 ? WS_WUP0 : WS_WUP1)), MTOK, DFF, DM}; pg8::StaticOrder S; S.init(MTOK, DFF, gridDim.x, lbid());
            pg8::EpiRelu2 E{(bf16_t*)(ws + WS_U), (const float*)(ws + WS_PART)}; pg8::gemm_phase(lds, g, S, E, wv0); } break;
        case 7: if (EN(7)) { const P p = load_params(); unsigned char* ws = p.ws;
                  pg8::Gemm g{(const bf16_t*)(ws + WS_HN), (const bf16_t*)(ws + WS_WQKV), MTOK, NQKV, DM}; pg8::StaticOrder S; S.init(MTOK, NQKV, gridDim.x, lbid());
                  pg8::EpiQKV E{ws, (const float*)(ws + WS_PART)}; pg8::gemm_phase(lds, g, S, E, wv0);
                  asm volatile("s_waitcnt vmcnt(0)" ::: "memory"); __syncthreads(); __builtin_amdgcn_fence(__ATOMIC_ACQUIRE, "agent"); asm volatile("s_waitcnt vmcnt(0)" ::: "memory");
                  pg8::Unit u; WL();
                  for (int i = 0; S.next(i, u); ++i) { if (u.pn == 4)
                          rope_tile((bf16_t*)(ws + WS_K) + (size_t)u.pm * 256 * NKV, NKV, u.pm * 256, p.in[I_KG], wave, lane); } } break;
        case 8: if (EN(8)) { const P p = load_params(); WL(); rope_phase(p, wave, lane, dry); } break;
        case 9: if (EN(9)) { const P p = load_params(); attn_phase(p, (char*)shm, dry, wv0); } break;
        case 13: if (EN(13)) { const P p = load_params(); WL(); GW(); final_norm_rows((const bf16_t*)(p.ws + WS_HN), p.in[I_FG], p.out, gw, ngw, lane); } break;
        default: break;
        }
        if ((((ph2 & 1) == 0) && ((REPMASK >> ph) & 1)) || ph + 1 < ph_hi) { if (ph_hi < 0) grid.sync();   { XcdBarrier xb2; xb2.bar = (unsigned*)(load_params().ws + WS_BAR); xb2.x = xb_xcc_id(); xb2.st = (volatile LAS unsigned*)(lds + LDS_MAIN); xcd_barrier(xb2, wv0); } ++nseam; }
    }
}

extern "C" void kernel_launch(void* const* d_in, const int* in_sizes, int n_in, void* d_out, int out_size, void* d_ws, size_t ws_size, hipStream_t stream) {
    static int grid = 0;
    if (grid == 0) {
        if (n_in != 19 || out_size != MTOK * DM || ws_size < WS_END) { fprintf(stderr, "kernel_launch: unexpected shapes n_in %d out %d ws %zu\n", n_in, out_size, ws_size); grid = -1; return; }
        int dev = 0, cus = 0, per_cu = 0;
        hipGetDevice(&dev);
        hipDeviceGetAttribute(&cus, hipDeviceAttributeMultiprocessorCount, dev);
        if (hipFuncSetAttribute((const void*)mega, hipFuncAttributeMaxDynamicSharedMemorySize, LDS_BYTES) != hipSuccess) { fprintf(stderr, "kernel_launch: hipFuncSetAttribute failed\n"); grid = -1; return; }
        hipOccupancyMaxActiveBlocksPerMultiprocessor(&per_cu, (const void*)mega, NTHREADS, LDS_BYTES);
        if (per_cu < 1) per_cu = 1;
        grid = cus * per_cu;
        (void)hipGetLastError();
    }
    if (grid < 0) return;
    P p{};
    for (int i = 0; i < 19; ++i) p.in[i] = (const float*)d_in[i];
    p.out = (float*)d_out; p.ws = (unsigned char*)d_ws;
#if ONE_LAUNCH
    p.ph_lo = 0; p.ph_hi = NPHASE;
    if (hipMemsetAsync((char*)d_ws + WS_BAR, 0, XCD_BAR_WORDS * 4, stream) != hipSuccess) { fprintf(stderr, "kernel_launch: memset of the barrier words failed\n"); return; }
    void* args[] = {&p};
    hipError_t e = hipLaunchCooperativeKernel((const void*)mega, dim3(grid), dim3(NTHREADS), args, LDS_BYTES, stream);
    if (e != hipSuccess) fprintf(stderr, "cooperative launch failed: %s (grid %d)\n", hipGetErrorString(e), grid);
#else
    for (int ph = 0; ph < NPHASE; ++ph) {
        p.ph_lo = ph; p.ph_hi = ph + 1;
        hipLaunchKernelGGL(mega, dim3(grid), dim3(NTHREADS), LDS_BYTES, stream, p);
    }
#endif
}
```

```cpp
#include <hip/hip_runtime.h>
#include <hip/hip_cooperative_groups.h>
#include <cstdio>
#include <cstdint>
namespace cg = cooperative_groups;

#ifndef ONE_LAUNCH
#define ONE_LAUNCH 1
#endif

#define LAS __attribute__((address_space(3)))
typedef unsigned short bf16_t;
typedef short bf16x8 __attribute__((ext_vector_type(8)));
typedef short s16x4 __attribute__((ext_vector_type(4)));
typedef float f32x4 __attribute__((ext_vector_type(4)));
typedef float f32x2 __attribute__((ext_vector_type(2)));
typedef float f32x16 __attribute__((ext_vector_type(16)));
typedef unsigned u32x4 __attribute__((ext_vector_type(4)));
typedef unsigned u32x2 __attribute__((ext_vector_type(2)));

constexpr int BATCH = 16, SEQ = 2048, DM = 1024, MTOK = BATCH * SEQ, DFF = 4096, NQKV = 1536, NKV = 256;
constexpr float EPS = 1e-6f;
constexpr int NTHREADS = 512, NWAVES = 8;
constexpr int LDS_MAIN = 131072;
constexpr int LDS_RS = LDS_MAIN + 16;
constexpr int LDS_BYTES = LDS_RS + 2048;

constexpr size_t MiB = 1024 * 1024;
constexpr size_t WS_WIN = 0, WS_WOUT = 4 * MiB, WS_WQKV = 6 * MiB, WS_WO = 9 * MiB, WS_WUP0 = 11 * MiB, WS_WUP1 = 19 * MiB,
                 WS_WDN0 = 27 * MiB, WS_WDN1 = 35 * MiB, WS_WG = 43 * MiB, WS_PART = 44 * MiB, WS_BAR = 46 * MiB, WS_HN = 48 * MiB, WS_U = 112 * MiB;
constexpr size_t WS_GATE = WS_U, WS_RECPRE = WS_U + 64 * MiB, WS_Y = WS_U + 128 * MiB, WS_HF = WS_U + 192 * MiB, WS_HB = WS_U + 256 * MiB;
constexpr size_t WS_Q = WS_U, WS_K = WS_U + 64 * MiB, WS_V = WS_U + 80 * MiB;
constexpr size_t WS_END = WS_U + 320 * MiB;

struct P {
    const float* in[19];
    float* out;
    unsigned char* ws;
    int ph_lo, ph_hi;
};
enum { I_X = 0, I_GMIX, I_GMLP, I_WIN, I_CONVW, I_CONVB, I_WA, I_BA, I_WX, I_BX, I_LAM, I_WOUT, I_WQKV, I_QG, I_KG, I_WO, I_WUP, I_WDN, I_FG };

__device__ __forceinline__ int ltid(int wv) { int t = wv * 64 + (int)__builtin_amdgcn_mbcnt_hi(~0u, __builtin_amdgcn_mbcnt_lo(~0u, 0u)); asm volatile("" : "+v"(t)); return t; }
__device__ __forceinline__ int lbid() { int b = blockIdx.x; asm volatile("" : "+s"(b)); return b; }
__device__ __forceinline__ unsigned pk2(float lo, float hi) { unsigned r; asm("v_cvt_pk_bf16_f32 %0, %1, %2" : "=v"(r) : "v"(lo), "v"(hi)); return r; }
__device__ __forceinline__ float bflo(unsigned w) { return __uint_as_float(w << 16); }
__device__ __forceinline__ float bfhi(unsigned w) { return __uint_as_float(w & 0xffff0000u); }
template <int K> __device__ __forceinline__ float lane_xor(float v) { return __int_as_float(__builtin_amdgcn_ds_swizzle(__float_as_int(v), (K << 10) | 0x1f)); }
__device__ __forceinline__ float sum_xor32(float v) { auto rr = __builtin_amdgcn_permlane32_swap(__float_as_uint(v), __float_as_uint(v), false, false); return __uint_as_float(rr[0]) + __uint_as_float(rr[1]); }
__device__ __forceinline__ float wave_sum(float v) {
    v += lane_xor<1>(v); v += lane_xor<2>(v); v += lane_xor<4>(v); v += lane_xor<8>(v); v += lane_xor<16>(v);
    return sum_xor32(v);
}
__device__ __forceinline__ float fsigmoid(float z) { return __builtin_amdgcn_rcpf(1.0f + __builtin_amdgcn_exp2f(-1.4426950408889634f * z)); }

namespace pg8 {
constexpr int BM = 256, BK = 64, HALF = 128, HTB = HALF * BK * 2, STAGE_BYTES = 8 * HTB, NXCD = 8, WGM = 8;
__host__ __device__ __forceinline__ int lds_byte(int r, int c) { const int st = (r >> 4) * 2 + (c >> 5), rr = r & 15, cc = c & 31, ob = rr * 64 + cc * 2; return st * 1024 + (ob ^ (((ob >> 9) & 1) << 5)); }
__host__ __device__ __forceinline__ void stage_rc(int b, int& R, int& C) { const int st = b / 1024, sb = b % 1024, swz = sb ^ (((sb >> 9) & 1) << 5); R = (st >> 1) * 16 + swz / 64; C = (st & 1) * 32 + (swz % 64) / 2; }
__host__ __device__ __forceinline__ int perm32(int rho) { const int n = rho >> 4, i = rho & 15; return 8 * (i >> 2) + 4 * n + (i & 3); }
struct Unit { int pm, pn; };
struct Gemm { const bf16_t* A; const bf16_t* Bt; int M, N, K; };
struct StaticOrder {
    int nM, nN, nwg, G, c;
    __device__ void init(int M, int N, int G_, int c_) { nM = M / BM; nN = N / BM; nwg = nM * nN; G = G_; c = c_; }
    __device__ bool next(int i, Unit& u) const {
        const long L = (long)i * G + c; if (L >= nwg) return false;
        int wgid = (int)L; { const int q = nwg / NXCD, r = nwg % NXCD, xcd = wgid % NXCD, off = wgid / NXCD; wgid = (xcd < r ? xcd * (q + 1) : r * (q + 1) + (xcd - r) * q) + off; }
        const int nig = WGM * nN, gid = wgid / nig, fm = gid * WGM, gsz = (nM - fm) < WGM ? (nM - fm) : WGM;
        u.pm = fm + ((wgid % nig) % gsz); u.pn = (wgid % nig) / gsz; return true;
    }
};

__device__ __forceinline__ void row_scales_load(const float* part, int row0, int fq, f32x4 (&t)[2][4]);
__device__ __forceinline__ void row_scales_reduce(const f32x4 (&t)[2][4], float (&rs)[2][4]);
template <class Epi>
__device__ __forceinline__ void gemm_phase(LAS unsigned char* lds, const Gemm g, const StaticOrder& S, const Epi& E, int wv) {
    const int tid = ltid(wv), wid = __builtin_amdgcn_readfirstlane(tid >> 6), lane = tid & 63, wr = wid >> 2, wc = wid & 3, fr = lane & 15, fq = lane >> 4;
    const int K = g.K, nt = K / BK;
    unsigned voffA[2], voffB[2];
#pragma unroll
    for (int i = 0; i < 2; ++i) { int R, C; stage_rc(tid * 16 + i * 8192, R, C); const int Rb = Epi::PERM ? ((R & ~31) + perm32(R & 31)) : R;
        voffA[i] = (unsigned)(R * K + C) * 2u; voffB[i] = (unsigned)(Rb * K + C) * 2u; }
    const size_t kstep = (size_t)(BK * 2);
    const size_t hstep = (size_t)HALF * K * 2;
    const size_t tstep = 2 * hstep;
    const unsigned ldsw = (unsigned)wid * 1024u;
    const int aoff = lds_byte(wr * 64 + fr, fq * 8), boff = lds_byte(wc * 32 + fr, fq * 8);
#define PG8_SA(b, h) (((b) * 2 + (h)) * HTB)
#define PG8_SB(b, h) ((4 + (b) * 2 + (h)) * HTB)
#define PG8_STAGE(bufoff, gbase, voff) do { _Pragma("unroll") for (int _i = 0; _i < 2; ++_i) \
        __builtin_amdgcn_global_load_lds((const unsigned*)((const char*)(gbase) + (voff)[_i]), (LAS unsigned*)(lds + (bufoff) + ldsw + _i * 8192), 16, 0, 0); } while (0)
#define PG8_LDA(dst, b, h) do { _Pragma("unroll") for (int m = 0; m < 4; ++m) _Pragma("unroll") for (int k = 0; k < 2; ++k) dst[m][k] = *(const LAS bf16x8*)(lds + PG8_SA(b, h) + aoff + m * 2048 + k * 1024); } while (0)
#define PG8_LDB(dst, b, h) do { _Pragma("unroll") for (int n = 0; n < 2; ++n) _Pragma("unroll") for (int k = 0; k < 2; ++k) dst[n][k] = *(const LAS bf16x8*)(lds + PG8_SB(b, h) + boff + n * 2048 + k * 1024); } while (0)
#define PG8_MMA(ai, bj, At, Bt) do { __builtin_amdgcn_s_setprio(1); _Pragma("unroll") for (int m = 0; m < 4; ++m) _Pragma("unroll") for (int n = 0; n < 2; ++n) _Pragma("unroll") for (int k = 0; k < 2; ++k) \
        acc[ai][bj][m][n] = __builtin_amdgcn_mfma_f32_16x16x32_bf16(Bt[n][k], At[m][k], acc[ai][bj][m][n], 0, 0, 0); __builtin_amdgcn_s_setprio(0); } while (0)
#define PG8_WAIT_V(n) asm volatile("s_waitcnt vmcnt(" #n ")" ::: "memory")
#define PG8_WAIT_L(n) asm volatile("s_waitcnt lgkmcnt(" #n ")" ::: "memory")
#define PG8_BAR __builtin_amdgcn_s_barrier()
#define PG8_SCHED __builtin_amdgcn_sched_barrier(0)
    Unit cur, nxt; int ui = 0;
    if (!S.next(0, cur)) return;
    f32x4 acc[2][2][4][2];
#pragma unroll
    for (int a = 0; a < 2; ++a)
#pragma unroll
        for (int b = 0; b < 2; ++b)
#pragma unroll
            for (int m = 0; m < 4; ++m)
#pragma unroll
                for (int n = 0; n < 2; ++n) acc[a][b][m][n] = (f32x4){0.f, 0.f, 0.f, 0.f};
    bf16x8 At[4][2], B0[2][2], B1[2][2];
    const char* cA = (const char*)g.A + (size_t)cur.pm * tstep; const char* cB = (const char*)g.Bt + (size_t)cur.pn * tstep;
    LAS float* rsl = (LAS float*)(lds + LDS_RS);
#define PG8_RS_LOAD(pm_, ta, tb) do { const float* _pp = E.part + ((size_t)(pm_) * BM + wid * 32 + (lane >> 1)) * 16 + (lane & 1) * 8; ta = *(const f32x4*)_pp; tb = *(const f32x4*)(_pp + 4); } while (0)
#define PG8_RS_PUBLISH(ta, tb, par) do { float _ss = ((ta[0] + ta[1]) + (ta[2] + ta[3])) + ((tb[0] + tb[1]) + (tb[2] + tb[3])); _ss += lane_xor<1>(_ss); \
        if (!(lane & 1)) rsl[(par) * 256 + wid * 32 + (lane >> 1)] = rsqrtf(_ss * (1.f / DM) + EPS); } while (0)
    f32x4 ta0, tb0; if constexpr (Epi::ROWSCALE) PG8_RS_LOAD(cur.pm, ta0, tb0);
    PG8_STAGE(PG8_SB(0, 0), cB, voffB); PG8_STAGE(PG8_SA(0, 0), cA, voffA); PG8_STAGE(PG8_SB(0, 1), cB + hstep, voffB); PG8_STAGE(PG8_SA(0, 1), cA + hstep, voffA);
    if (wr == 1) PG8_BAR;
    PG8_WAIT_V(4); PG8_BAR;
    PG8_STAGE(PG8_SB(1, 0), cB + kstep, voffB); PG8_STAGE(PG8_SA(1, 0), cA + kstep, voffA); PG8_STAGE(PG8_SB(1, 1), cB + hstep + kstep, voffB);
    PG8_WAIT_V(6); PG8_BAR;
    if constexpr (Epi::ROWSCALE) PG8_RS_PUBLISH(ta0, tb0, 0);
    for (;;) {
        const bool has_next = S.next(ui + 1, nxt);
        const char* nA = has_next ? (const char*)g.A + (size_t)nxt.pm * tstep : cA; const char* nB = has_next ? (const char*)g.Bt + (size_t)nxt.pn * tstep : cB;
        for (int t = 0; t < nt; t += 2) {
            const bool last = (t == nt - 2);
            const char* a1 = cA + (size_t)(t + 1) * kstep;
            const char* a2 = last ? nA : cA + (size_t)(t + 2) * kstep; const char* b2 = last ? nB : cB + (size_t)(t + 2) * kstep;
            const char* a3 = a2 + kstep; const char* b3 = b2 + kstep;
            PG8_LDB(B0, 0, 0); PG8_SCHED; PG8_LDA(At, 0, 0); PG8_STAGE(PG8_SA(1, 1), a1 + hstep, voffA);
            PG8_WAIT_L(8); PG8_BAR; PG8_WAIT_L(0); PG8_MMA(0, 0, At, B0); PG8_BAR; PG8_SCHED;
            PG8_LDB(B1, 0, 1); PG8_STAGE(PG8_SB(0, 0), b2, voffB);
            PG8_BAR; PG8_WAIT_L(0); PG8_MMA(0, 1, At, B1); PG8_BAR;
            PG8_LDA(At, 0, 1); PG8_STAGE(PG8_SA(0, 0), a2, voffA);
            PG8_BAR; PG8_WAIT_L(0); PG8_MMA(1, 0, At, B0); PG8_BAR; PG8_SCHED;
            PG8_STAGE(PG8_SB(0, 1), b2 + hstep, voffB);
            PG8_WAIT_V(6); PG8_BAR; PG8_MMA(1, 1, At, B1); PG8_BAR;
            PG8_LDB(B0, 1, 0); PG8_SCHED; PG8_LDA(At, 1, 0); PG8_STAGE(PG8_SA(0, 1), a2 + hstep, voffA);
            PG8_WAIT_L(8); PG8_BAR; PG8_WAIT_L(0); PG8_MMA(0, 0, At, B0); PG8_BAR; PG8_SCHED;
            PG8_LDB(B1, 1, 1); PG8_STAGE(PG8_SB(1, 0), b3, voffB);
            PG8_BAR; PG8_WAIT_L(0); PG8_MMA(0, 1, At, B1); PG8_BAR;
            PG8_LDA(At, 1, 1); PG8_STAGE(PG8_SA(1, 0), a3, voffA);
            PG8_BAR; PG8_WAIT_L(0); PG8_MMA(1, 0, At, B0); PG8_BAR; PG8_SCHED;
            PG8_STAGE(PG8_SB(1, 1), b3 + hstep, voffB);
            PG8_WAIT_V(6); PG8_BAR; PG8_MMA(1, 1, At, B1); PG8_BAR;
        }
        if constexpr (Epi::ROWSCALE) { f32x4 ta, tb; if (has_next) PG8_RS_LOAD(nxt.pm, ta, tb);
            E(acc, cur, wr, wc, fr, fq, rsl + (ui & 1) * 256); if (has_next) PG8_RS_PUBLISH(ta, tb, (ui + 1) & 1); }
        else E(acc, cur, wr, wc, fr, fq, rsl);
        if (!has_next) break;
#pragma unroll
        for (int a = 0; a < 2; ++a)
#pragma unroll
            for (int b = 0; b < 2; ++b)
#pragma unroll
                for (int m = 0; m < 4; ++m)
#pragma unroll
                    for (int n = 0; n < 2; ++n) acc[a][b][m][n] = (f32x4){0.f, 0.f, 0.f, 0.f};
        cur = nxt; cA = nA; cB = nB; ++ui;
    }
    PG8_WAIT_V(0);
    if (wr == 0) PG8_BAR;
    PG8_BAR;
#undef PG8_RS_PUBLISH
#undef PG8_RS_LOAD
#undef PG8_SA
#undef PG8_SB
#undef PG8_STAGE
#undef PG8_LDA
#undef PG8_LDB
#undef PG8_MMA
#undef PG8_WAIT_V
#undef PG8_WAIT_L
#undef PG8_BAR
#undef PG8_SCHED
}

__device__ __forceinline__ float gelu_tanh(float x) {
    const float y = 1.5957691216057308f * (x + 0.044715f * x * x * x);
    return x * fsigmoid(y);
}
template <int MODE> __device__ __forceinline__ void store8(bf16_t* p, f32x4 v0, f32x4 v1, float rs) {
    f32x2 a = {v0[0], v0[1]}, b = {v0[2], v0[3]}, c = {v1[0], v1[1]}, d = {v1[2], v1[3]};
    a = a * rs; b = b * rs; c = c * rs; d = d * rs;
    if (MODE == 1) {
        a.x = gelu_tanh(a.x); a.y = gelu_tanh(a.y); b.x = gelu_tanh(b.x); b.y = gelu_tanh(b.y); c.x = gelu_tanh(c.x); c.y = gelu_tanh(c.y); d.x = gelu_tanh(d.x); d.y = gelu_tanh(d.y);
    }
    if (MODE == 2) {
        const f32x2 z = {0.f, 0.f};
        a = __builtin_elementwise_max(a, z); b = __builtin_elementwise_max(b, z); c = __builtin_elementwise_max(c, z); d = __builtin_elementwise_max(d, z);
        a = a * a; b = b * b; c = c * c; d = d * d;
    }
    u32x4 w; w.x = pk2(a.x, a.y); w.y = pk2(b.x, b.y); w.z = pk2(c.x, c.y); w.w = pk2(d.x, d.y);
    *(u32x4*)p = w;
}
__device__ __forceinline__ float row_rs(const float* part, int row) {
    const f32x4* pp = (const f32x4*)(part + (size_t)row * 16); const f32x4 a = pp[0], b = pp[1], c = pp[2], d = pp[3];
    const float ss = ((a[0] + a[1]) + (a[2] + a[3])) + ((b[0] + b[1]) + (b[2] + b[3])) + ((c[0] + c[1]) + (c[2] + c[3])) + ((d[0] + d[1]) + (d[2] + d[3]));
    return rsqrtf(ss * (1.f / DM) + EPS);
}
__device__ __forceinline__ void row_scales_load(const float* part, int row0, int fq, f32x4 (&t)[2][4]) {
#pragma unroll
    for (int ai = 0; ai < 2; ++ai)
#pragma unroll
        for (int m = 0; m < 4; ++m) t[ai][m] = *(const f32x4*)(part + (size_t)(row0 + ai * HALF + m * 16) * 16 + fq * 4);
}
__device__ __forceinline__ void row_scales_reduce(const f32x4 (&t)[2][4], float (&rs)[2][4]) {
#pragma unroll
    for (int ai = 0; ai < 2; ++ai)
#pragma unroll
        for (int m = 0; m < 4; ++m) { float ss = (t[ai][m][0] + t[ai][m][1]) + (t[ai][m][2] + t[ai][m][3]); ss += lane_xor<16>(ss); ss = sum_xor32(ss); rs[ai][m] = rsqrtf(ss * (1.f / DM) + EPS); }
}
struct EpiWin {
    static constexpr bool PERM = true, ROWSCALE = true;
    bf16_t* gate; bf16_t* rec; const float* part;
    __device__ __forceinline__ void operator()(const f32x4 (&acc)[2][2][4][2], const Unit& u, int wr, int wc, int fr, int fq, const LAS float* rsl) const {
        const int row0 = u.pm * BM + wr * 64 + fr; const bool isg = u.pn < 4; bf16_t* base = isg ? gate : rec;
        const int col0 = (u.pn & 3) * BM + wc * 32 + 8 * fq;
#pragma unroll
        for (int ai = 0; ai < 2; ++ai)
#pragma unroll
            for (int m = 0; m < 4; ++m) { bf16_t* rowp = base + (size_t)(row0 + ai * HALF + m * 16) * DM + col0; const float rs = rsl[ai * HALF + wr * 64 + m * 16 + fr];
#pragma unroll
                for (int bj = 0; bj < 2; ++bj) { if (isg) store8<1>(rowp + bj * HALF, acc[ai][bj][m][0], acc[ai][bj][m][1], rs); else store8<0>(rowp + bj * HALF, acc[ai][bj][m][0], acc[ai][bj][m][1], rs); } }
    }
};
struct EpiRelu2 {
    static constexpr bool PERM = true, ROWSCALE = true;
    bf16_t* U; const float* part;
    __device__ __forceinline__ void operator()(const f32x4 (&acc)[2][2][4][2], const Unit& u, int wr, int wc, int fr, int fq, const LAS float* rsl) const {
        const int row0 = u.pm * BM + wr * 64 + fr; const int col0 = u.pn * BM + wc * 32 + 8 * fq;
#pragma unroll
        for (int ai = 0; ai < 2; ++ai)
#pragma unroll
            for (int m = 0; m < 4; ++m) { const int row = row0 + ai * HALF + m * 16; bf16_t* rowp = U + (size_t)row * DFF + col0;
                const float rs = rsl[ai * HALF + wr * 64 + m * 16 + fr];
#pragma unroll
                for (int bj = 0; bj < 2; ++bj) store8<2>(rowp + bj * HALF, acc[ai][bj][m][0], acc[ai][bj][m][1], rs); }
    }
};
struct EpiQKV {
    static constexpr bool PERM = true, ROWSCALE = true;
    unsigned char* ws; const float* part;
    __device__ __forceinline__ void operator()(const f32x4 (&acc)[2][2][4][2], const Unit& u, int wr, int wc, int fr, int fq, const LAS float* rsl) const {
        const int row0 = u.pm * BM + wr * 64 + fr;
        const bool isq = u.pn < 4; bf16_t* base = (bf16_t*)(ws + WS_Q + (isq ? (size_t)0 : (size_t)(64 + 16 * (u.pn - 4)) * MiB)); const int ldc = isq ? DM : NKV; const int colt = isq ? u.pn * BM : 0;
        const int col0 = colt + wc * 32 + 8 * fq;
#pragma unroll
        for (int ai = 0; ai < 2; ++ai)
#pragma unroll
            for (int m = 0; m < 4; ++m) { const int row = row0 + ai * HALF + m * 16; bf16_t* rowp = base + (size_t)row * ldc + col0;
                const float rs = rsl[ai * HALF + wr * 64 + m * 16 + fr];
#pragma unroll
                for (int bj = 0; bj < 2; ++bj) store8<0>(rowp + bj * HALF, acc[ai][bj][m][0], acc[ai][bj][m][1], rs); }
    }
};
struct EpiResid {
    static constexpr bool PERM = true, ROWSCALE = false;
    bf16_t* xb; float* part; int stats;
    __device__ __forceinline__ void operator()(const f32x4 (&acc)[2][2][4][2], const Unit& u, int wr, int wc, int fr, int fq, const LAS float* rsl) const {
        const int row0 = u.pm * BM + wr * 64 + fr, col0 = u.pn * BM + wc * 32 + 8 * fq;
        u32x4 bsa[2][4][2];
#pragma unroll
        for (int ai = 0; ai < 2; ++ai)
#pragma unroll
            for (int m = 0; m < 4; ++m)
#pragma unroll
                for (int bj = 0; bj < 2; ++bj) bsa[ai][m][bj] = *(const u32x4*)(xb + (size_t)(row0 + ai * HALF + m * 16) * DM + col0 + bj * HALF);
        asm volatile("" ::: "memory");
#pragma unroll
        for (int ai = 0; ai < 2; ++ai)
#pragma unroll
            for (int m = 0; m < 4; ++m) { const int row = row0 + ai * HALF + m * 16; bf16_t* rowp = xb + (size_t)row * DM + col0;
                float ss = 0.f;
#pragma unroll
                for (int bj = 0; bj < 2; ++bj) { const u32x4 b = bsa[ai][m][bj]; const f32x4 a0 = acc[ai][bj][m][0], a1 = acc[ai][bj][m][1];
                    const float v0 = bflo(b.x) + a0[0], v1 = bfhi(b.x) + a0[1], v2 = bflo(b.y) + a0[2], v3 = bfhi(b.y) + a0[3];
                    const float v4 = bflo(b.z) + a1[0], v5 = bfhi(b.z) + a1[1], v6 = bflo(b.w) + a1[2], v7 = bfhi(b.w) + a1[3];
                    ss += ((v0 * v0 + v1 * v1) + (v2 * v2 + v3 * v3)) + ((v4 * v4 + v5 * v5) + (v6 * v6 + v7 * v7));
                    u32x4 w; w.x = pk2(v0, v1); w.y = pk2(v2, v3); w.z = pk2(v4, v5); w.w = pk2(v6, v7);
                    *(u32x4*)(rowp + bj * HALF) = w; }
                if (stats) { ss += lane_xor<16>(ss); ss = sum_xor32(ss); if (fq == 0) part[(size_t)row * 16 + u.pn * 4 + wc] = ss; } }
    }
};
}

__device__ __forceinline__ void transpose_item(const float* W, int K, int N, bf16_t* WT, int row_off, LAS float* scr, int item, int lane, const float* gk = nullptr) {
    const int nblk = N / 32, kb = item / nblk, nb = item % nblk, k0 = 64 * kb, n0 = 32 * nb;
    float tv[32];
#pragma unroll
    for (int i = 0; i < 32; ++i) tv[i] = __builtin_nontemporal_load(W + (size_t)(k0 + 2 * i + (lane >> 5)) * N + n0 + (lane & 31));
#pragma unroll
    for (int i = 0; i < 32; ++i) scr[(2 * i + (lane >> 5)) * 33 + (lane & 31)] = tv[i];
    asm volatile("s_waitcnt lgkmcnt(0)" ::: "memory");
    const int c = lane & 7;
#pragma unroll
    for (int j = 0; j < 4; ++j) { const int n = (lane >> 3) + 8 * j; const LAS float* s = scr + (8 * c) * 33 + n;
        f32x4 g0 = (f32x4){1.f, 1.f, 1.f, 1.f}, g1 = g0; if (gk) { g0 = *(const f32x4*)(gk + k0 + 8 * c); g1 = *(const f32x4*)(gk + k0 + 8 * c + 4); }
        u32x4 o; o.x = pk2(s[0 * 33] * g0[0], s[1 * 33] * g0[1]); o.y = pk2(s[2 * 33] * g0[2], s[3 * 33] * g0[3]); o.z = pk2(s[4 * 33] * g1[0], s[5 * 33] * g1[1]); o.w = pk2(s[6 * 33] * g1[2], s[7 * 33] * g1[3]);
        *(u32x4*)(WT + (size_t)(row_off + n0 + n) * K + k0 + 8 * c) = o; }
    asm volatile("s_waitcnt lgkmcnt(0)" ::: "memory");
}
__device__ __forceinline__ void norm_rows_bf16(const float* src, const float* g, bf16_t* dst, int gw, int ngw, int lane) {
    f32x4 gv[4];
#pragma unroll
    for (int j = 0; j < 4; ++j) gv[j] = *((const f32x4*)g + lane + 64 * j);
    for (int m = gw; m < MTOK; m += ngw) {
        const f32x4* xr = (const f32x4*)(src + (size_t)m * DM) + lane;
        f32x4 v[4]; float s = 0.f;
#pragma unroll
        for (int j = 0; j < 4; ++j) { v[j] = xr[64 * j]; s += (v[j].x * v[j].x + v[j].y * v[j].y) + (v[j].z * v[j].z + v[j].w * v[j].w); }
        const float rs = rsqrtf(wave_sum(s) * (1.f / DM) + EPS);
        u32x2* o8 = (u32x2*)(dst + (size_t)m * DM) + lane;
#pragma unroll
        for (int j = 0; j < 4; ++j) { u32x2 w; w.x = pk2(v[j].x * rs * gv[j].x, v[j].y * rs * gv[j].y); w.y = pk2(v[j].z * rs * gv[j].z, v[j].w * rs * gv[j].w); o8[64 * j] = w; }
    }
}
__device__ __forceinline__ void xb_rows(const float* src, bf16_t* dst, float* part, int gw, int ngw, int lane) {
    for (int m = 4 * gw; m < MTOK; m += 4 * ngw) {
        f32x4 v[4][4];
#pragma unroll
        for (int u = 0; u < 4; ++u)
#pragma unroll
            for (int j = 0; j < 4; ++j) v[u][j] = __builtin_nontemporal_load((const f32x4*)(src + (size_t)(m + u) * DM) + lane + 64 * j);
#pragma unroll
        for (int u = 0; u < 4; ++u) {
            float s = 0.f;
#pragma unroll
            for (int j = 0; j < 4; ++j) s += (v[u][j].x * v[u][j].x + v[u][j].y * v[u][j].y) + (v[u][j].z * v[u][j].z + v[u][j].w * v[u][j].w);
            s = wave_sum(s);
            u32x2* o8 = (u32x2*)(dst + (size_t)(m + u) * DM) + lane;
#pragma unroll
            for (int j = 0; j < 4; ++j) { u32x2 w; w.x = pk2(v[u][j].x, v[u][j].y); w.y = pk2(v[u][j].z, v[u][j].w); o8[64 * j] = w; }
            if (lane < 16) part[(size_t)(m + u) * 16 + lane] = lane == 0 ? s : 0.f;
        }
    }
}
__device__ __forceinline__ void final_norm_rows(const bf16_t* src, const float* g, float* dst, int gw, int ngw, int lane) {
    f32x4 gv[4];
#pragma unroll
    for (int j = 0; j < 4; ++j) gv[j] = *((const f32x4*)g + lane + 64 * j);
    for (int m = 4 * gw; m < MTOK; m += 4 * ngw) {
        u32x2 w[4][4];
#pragma unroll
        for (int u = 0; u < 4; ++u)
#pragma unroll
            for (int j = 0; j < 4; ++j) w[u][j] = *((const u32x2*)(src + (size_t)(m + u) * DM) + lane + 64 * j);
#pragma unroll
        for (int u = 0; u < 4; ++u) {
            f32x4 v[4]; float s = 0.f;
#pragma unroll
            for (int j = 0; j < 4; ++j) { v[j] = (f32x4){bflo(w[u][j].x), bfhi(w[u][j].x), bflo(w[u][j].y), bfhi(w[u][j].y)}; s += (v[j].x * v[j].x + v[j].y * v[j].y) + (v[j].z * v[j].z + v[j].w * v[j].w); }
            const float rs = rsqrtf(wave_sum(s) * (1.f / DM) + EPS);
            f32x4* o = (f32x4*)(dst + (size_t)(m + u) * DM) + lane;
#pragma unroll
            for (int j = 0; j < 4; ++j) __builtin_nontemporal_store(v[j] * rs * gv[j], o + 64 * j);
        }
    }
}
__device__ __forceinline__ void norm_rows_f32_inplace(float* buf, const float* g, int gw, int ngw, int lane) {
    f32x4 gv[4];
#pragma unroll
    for (int j = 0; j < 4; ++j) gv[j] = *((const f32x4*)g + lane + 64 * j);
    for (int m = gw; m < MTOK; m += ngw) {
        f32x4* xr = (f32x4*)(buf + (size_t)m * DM) + lane;
        f32x4 v[4]; float s = 0.f;
#pragma unroll
        for (int j = 0; j < 4; ++j) { v[j] = xr[64 * j]; s += (v[j].x * v[j].x + v[j].y * v[j].y) + (v[j].z * v[j].z + v[j].w * v[j].w); }
        const float rs = rsqrtf(wave_sum(s) * (1.f / DM) + EPS);
#pragma unroll
        for (int j = 0; j < 4; ++j) xr[64 * j] = v[j] * rs * gv[j];
    }
}

__device__ __forceinline__ void prep_phase(const P& p, LAS unsigned char* lds, int wave, int lane) {
    LAS float* scr = (LAS float*)(lds + wave * 16384);
    const int gw = lbid() * NWAVES + wave, ngw = gridDim.x * NWAVES;
    unsigned char* ws = p.ws;
    constexpr int IT_WIN = 16 * 64, IT_WOUT = 16 * 32, IT_WQKV = 16 * 48, IT_WO = 16 * 32, IT_UP = 16 * 128, IT_DN = 64 * 32, IT_G = 32 * 8;
    constexpr int NIT = IT_WIN + IT_G;
    (void)IT_WOUT; (void)IT_WQKV; (void)IT_WO; (void)IT_UP; (void)IT_DN;
    for (int it = gw; it < NIT; it += ngw) {
        int r = it;
        if (r < IT_WIN) { transpose_item(p.in[I_WIN], DM, 2 * DM, (bf16_t*)(ws + WS_WIN), 0, scr, r, lane, p.in[I_GMIX]); continue; } r -= IT_WIN;
        {
            const int mi = r >> 3, sub = r & 7, ax = mi >> 4, d = (mi >> 3) & 1, h = mi & 7;
            const float* W = (ax ? p.in[I_WX] : p.in[I_WA]) + (size_t)(d * 8 + h) * 128 * 128;
            transpose_item(W, 128, 128, (bf16_t*)(ws + WS_WG) + (size_t)h * 512 * 128, (d * 2 + ax) * 128, scr, sub, lane);
        }
    }
    xb_rows(p.in[I_X], (bf16_t*)(ws + WS_HN), (float*)(ws + WS_PART), gw, ngw, lane);
}

constexpr int TL = 64, NCHK = SEQ / TL;
constexpr int A_PITCH = 272, H_PITCH = 132;
constexpr int L_A = 0, L_H = 17408, L_CW = L_H + 33792, L_RAW = L_CW + 2560;
static_assert(L_RAW + 68 * 256 <= LDS_MAIN, "lds");

template <bool REV>
__device__ __forceinline__ void lru_scan(f32x4 (&av)[4], f32x4 (&uv)[4], float& S, int fr, int fq) {
    const int fqe = REV ? 3 - fq : fq;
    const bool g1 = fqe >= 1, g2 = fqe >= 2, g3 = fqe >= 3;
    float Ak[4][4], Hk[4][4];
#pragma unroll
    for (int mi = 0; mi < 4; ++mi) {
        const int m = REV ? 3 - mi : mi;
        const f32x4 a = av[m], u = uv[m];
        float Hl, Al;
        if (!REV) { Hl = u[0]; Al = a[0]; Hl = a[1] * Hl + u[1]; Al *= a[1]; Hl = a[2] * Hl + u[2]; Al *= a[2]; Hl = a[3] * Hl + u[3]; Al *= a[3]; }
        else      { Hl = u[3]; Al = a[3]; Hl = a[2] * Hl + u[2]; Al *= a[2]; Hl = a[1] * Hl + u[1]; Al *= a[1]; Hl = a[0] * Hl + u[0]; Al *= a[0]; }
#pragma unroll
        for (int k = 0; k < 4; ++k) { const int src = fr + 16 * (REV ? 3 - k : k); Ak[mi][k] = __shfl(Al, src); Hk[mi][k] = __shfl(Hl, src); }
    }
#pragma unroll
    for (int mi = 0; mi < 4; ++mi) {
        const int m = REV ? 3 - mi : mi;
        const f32x4 a = av[m]; f32x4 u = uv[m];
        const float S0 = S, S1 = Ak[mi][0] * S0 + Hk[mi][0], S2 = Ak[mi][1] * S1 + Hk[mi][1], S3 = Ak[mi][2] * S2 + Hk[mi][2];
        S = Ak[mi][3] * S3 + Hk[mi][3];
        float prev = S0; prev = g1 ? S1 : prev; prev = g2 ? S2 : prev; prev = g3 ? S3 : prev;
        if (!REV) {
#pragma unroll
            for (int j = 0; j < 4; ++j) { prev = a[j] * prev + u[j]; u[j] = prev; }
        } else {
#pragma unroll
            for (int j = 3; j >= 0; --j) { prev = a[j] * prev + u[j]; u[j] = prev; }
        }
        uv[m] = u;
    }
}

#define XB_TMO      128
#define XB_XCNT(j)  (256  + 64 * (j))
#define XB_XSUB(j)  (1280 + 64 * (j))
#define XB_XGEN(j)  (2304 + 64 * (j))
#define XB_TOP      3328
#define XB_TOPGEN   3392
#define XCD_BAR_WORDS 3456
#define XB_SPIN_CAP (1u << 20)
__device__ __forceinline__ unsigned xb_ld(unsigned* p)              { return __hip_atomic_load(p, __ATOMIC_RELAXED, __HIP_MEMORY_SCOPE_AGENT); }
__device__ __forceinline__ unsigned xb_add(unsigned* p, unsigned v) { return __hip_atomic_fetch_add(p, v, __ATOMIC_RELAXED, __HIP_MEMORY_SCOPE_AGENT); }
__device__ __forceinline__ unsigned xb_xcc_id() { return (unsigned)__builtin_amdgcn_s_getreg((3 << 11) | 20) & 0xFu; }
#define XB_SPIN(cond, bar) do { unsigned _sp = 0; while (cond) { __builtin_amdgcn_s_sleep(1); \
    if ((++_sp & 255u) == 0u) { if (xb_ld(&(bar)[XB_TMO])) break; if (_sp > XB_SPIN_CAP) { atomicAdd(&(bar)[XB_TMO], 1u); break; } } } } while (0)
struct XcdBarrier { unsigned* bar; unsigned x; volatile LAS unsigned* st; };
__device__ __forceinline__ XcdBarrier xcd_barrier_post(unsigned* bar, volatile LAS unsigned* st) {
    XcdBarrier b; b.bar = bar; b.x = xb_xcc_id(); b.st = st;
    if (threadIdx.x == 0) (void)xb_add(&bar[XB_XCNT(b.x)], 1u);
    return b;
}
__device__ __forceinline__ void xcd_barrier_complete(unsigned* bar, unsigned x, unsigned& nloc, unsigned& nx) {
    const unsigned G = gridDim.x * gridDim.y * gridDim.z;
    unsigned sum, cnt, mine, sp = 0u;
    for (;;) {
        sum = 0u; cnt = 0u; mine = 0u;
#pragma nounroll
        for (unsigned j = 0; j < 16; ++j) { const unsigned c = xb_ld(&bar[XB_XCNT(j)]); sum += c; cnt += (c > 0u) ? 1u : 0u; mine = (j == x) ? c : mine; }
        if (sum == G) break;
        __builtin_amdgcn_s_sleep(1);
        if ((++sp & 255u) == 0u) { if (xb_ld(&bar[XB_TMO])) break; if (sp > XB_SPIN_CAP) { atomicAdd(&bar[XB_TMO], 1u); break; } }
    }
    nloc = mine > 0u ? mine : 1u; nx = cnt > 0u ? cnt : 1u;
}
__device__ __forceinline__ void xcd_barrier(const XcdBarrier& b, int wv) {
    asm volatile("s_waitcnt vmcnt(0)" ::: "memory");
    __syncthreads();
    unsigned* bar = b.bar; const unsigned bx = b.x;
    if (wv == 0 && __builtin_amdgcn_mbcnt_hi(~0u, __builtin_amdgcn_mbcnt_lo(~0u, 0u)) == 0u) {
        __builtin_amdgcn_s_waitcnt(0);
        unsigned nloc = b.st[0], nx = b.st[1];
        if (nloc == 0u) { xcd_barrier_complete(bar, bx, nloc, nx); b.st[0] = nloc; b.st[1] = nx; }
        const unsigned old = xb_add(&bar[XB_XSUB(bx)], 1u);
        const unsigned gen = old / nloc;
        if (old + 1u == (gen + 1u) * nloc) {
            __builtin_amdgcn_fence(__ATOMIC_RELEASE, "agent");
            asm volatile("s_waitcnt vmcnt(0)" ::: "memory");
            const unsigned og = xb_add(&bar[XB_TOP], 1u);
            const unsigned tg = og / nx;
            if (og + 1u == (tg + 1u) * nx) xb_add(&bar[XB_TOPGEN], 1u);
            else XB_SPIN(xb_ld(&bar[XB_TOPGEN]) == tg, bar);
            __builtin_amdgcn_fence(__ATOMIC_ACQUIRE, "agent");
            xb_add(&bar[XB_XGEN(bx)], 1u);
            asm volatile("s_waitcnt vmcnt(0)" ::: "memory");
        } else {
            XB_SPIN(xb_ld(&bar[XB_XGEN(bx)]) == gen, bar);
            __builtin_amdgcn_fence(__ATOMIC_ACQUIRE, "agent");
            asm volatile("s_waitcnt vmcnt(0)" ::: "memory");
        }
    }
    __syncthreads();
}

constexpr int WC_OUT = 0, WC_QKV = WC_OUT + (DM / 16) * (DM / 32), WC_O = WC_QKV + (DM / 16) * (NQKV / 32), WC_UP0 = WC_O + (DM / 16) * (DM / 32), WC_UP1 = WC_UP0 + (DM / 16) * (DFF / 32),
              WC_DN0 = WC_UP1 + (DM / 16) * (DFF / 32), WC_DN1 = WC_DN0 + (DFF / 16) * (DM / 32), WC_END = WC_DN1 + (DFF / 16) * (DM / 32);
struct WcItem { const float* src; bf16_t* dst; const float* gk; int N; };
template <int K, int N> __device__ __forceinline__ WcItem wconv_mk(const float* W, bf16_t* WT, const float* gk, int r, int lane) {
    constexpr int nblk = N / 32; const int k0 = (r / nblk) * 16 + (lane >> 5) * 8, n = (r % nblk) * 32 + (lane & 31);
    return WcItem{W + (size_t)k0 * N + n, WT + (size_t)n * K + k0, gk ? gk + k0 : nullptr, N};
}
__device__ __forceinline__ WcItem wconv_decode(const P& p, int idx, int lane) {
    unsigned char* ws = p.ws;
    if (idx < WC_QKV) return wconv_mk<DM, DM>(p.in[I_WOUT], (bf16_t*)(ws + WS_WOUT), nullptr, idx - WC_OUT, lane);
    if (idx < WC_O)   return wconv_mk<DM, NQKV>(p.in[I_WQKV], (bf16_t*)(ws + WS_WQKV), p.in[I_GMIX] + DM, idx - WC_QKV, lane);
    if (idx < WC_UP0) return wconv_mk<DM, DM>(p.in[I_WO], (bf16_t*)(ws + WS_WO), nullptr, idx - WC_O, lane);
    if (idx < WC_UP1) return wconv_mk<DM, DFF>(p.in[I_WUP], (bf16_t*)(ws + WS_WUP0), p.in[I_GMLP], idx - WC_UP0, lane);
    if (idx < WC_DN0) return wconv_mk<DM, DFF>(p.in[I_WUP] + (size_t)DM * DFF, (bf16_t*)(ws + WS_WUP1), p.in[I_GMLP] + DM, idx - WC_UP1, lane);
    if (idx < WC_DN1) return wconv_mk<DFF, DM>(p.in[I_WDN], (bf16_t*)(ws + WS_WDN0), nullptr, idx - WC_DN0, lane);
    return wconv_mk<DFF, DM>(p.in[I_WDN] + (size_t)DM * DFF, (bf16_t*)(ws + WS_WDN1), nullptr, idx - WC_DN1, lane);
}
__device__ __forceinline__ void wconv_load(const WcItem& t, float (&v)[8]) {
#pragma unroll
    for (int e = 0; e < 8; ++e) v[e] = __builtin_nontemporal_load(t.src + (size_t)e * t.N);
}
__device__ __forceinline__ void wconv_store(const WcItem& t, const float (&v)[8]) {
    f32x4 g0 = (f32x4){1.f, 1.f, 1.f, 1.f}, g1 = g0; if (t.gk) { g0 = *(const f32x4*)(t.gk); g1 = *(const f32x4*)(t.gk + 4); }
    u32x4 o; o.x = pk2(v[0] * g0[0], v[1] * g0[1]); o.y = pk2(v[2] * g0[2], v[3] * g0[3]); o.z = pk2(v[4] * g1[0], v[5] * g1[1]); o.w = pk2(v[6] * g1[2], v[7] * g1[3]);
    *(u32x4*)t.dst = o;
}
__device__ __forceinline__ void lru_mid_barrier(unsigned char* ws, LAS unsigned char* lds, int wv) {
    unsigned char* w = ws; asm volatile("" : "+s"(w));
    XcdBarrier xb; xb.bar = (unsigned*)(w + WS_BAR); xb.x = xb_xcc_id(); xb.st = (volatile LAS unsigned*)(lds + LDS_MAIN);
    xcd_barrier(xb, wv);
}
__device__ __forceinline__ void lru_phase(const P& p, LAS unsigned char* lds, int wv) {
    const int tid = ltid(wv), wid = __builtin_amdgcn_readfirstlane(tid >> 6), lane = tid & 63, fr = lane & 15, fq = lane >> 4;
    const bf16_t* RECPRE = (const bf16_t*)(p.ws + WS_RECPRE);
    const bf16_t* WG = (const bf16_t*)(p.ws + WS_WG);
    const int cv = tid & 15, tp = tid >> 4, lt0 = 2 * tp;
    LAS float* cw = (LAS float*)(lds + L_CW);
    LAS float* hbuf = (LAS float*)(lds + L_H);
    const bf16_t* GATE = (const bf16_t*)(p.ws + WS_GATE);
    bf16_t* Y = (bf16_t*)(p.ws + WS_Y);
    const int G = gridDim.x, ngi = (256 + G - 1) / G;
    const int ngw = G * NWAVES; int widx = lbid() * NWAVES + wid;
    for (int gi = 0; gi < ngi; ++gi) {
        const int grp = lbid() + gi * G;
        if (grp >= 256) { lru_mid_barrier(p.ws, lds, wv); continue; }
        const int d = grp & 1, h = (grp >> 1) & 7, b = grp >> 4;
        bf16_t* HD = (bf16_t*)(p.ws + (d ? WS_HB : WS_HF));
        const bf16_t* HP = (const bf16_t*)(p.ws + (d ? WS_HF : WS_HB));
        bf16x8 bfr[2][4];
#pragma unroll
        for (int nn = 0; nn < 2; ++nn)
#pragma unroll
            for (int kk = 0; kk < 4; ++kk) { const int row = (d * 2 + nn) * 128 + wid * 16 + fr;
                bfr[nn][kk] = *(const bf16x8*)(WG + ((size_t)h * 512 + row) * 128 + kk * 32 + fq * 8); }
        const int chl = wid * 16 + fr, chg = d * DM + h * 128 + chl;
        const float nba = -1.4426950408889634f * p.in[I_BA][chg], nbx = -1.4426950408889634f * p.in[I_BX][chg], clu = -8.0f * log1pf(expf(-p.in[I_LAM][chg]));
        __syncthreads();
        for (int i = tid; i < 640; i += NTHREADS) { const int tap = i >> 7, ch = i & 127; cw[i] = tap < 4 ? p.in[I_CONVW][tap * DM + h * 128 + ch] : p.in[I_CONVB][h * 128 + ch]; }
#define LRU_DMA_ROWS(c) do { _Pragma("unroll") for (int qi = 0; qi < 3; ++qi) { const int qq = wid + 8 * qi; if (qq < 17) { \
            int t = (c) * TL + 4 * qq + (lane >> 4) - 2; t = t < 0 ? 0 : (t > SEQ - 1 ? SEQ - 1 : t); \
            __builtin_amdgcn_global_load_lds((const unsigned*)(RECPRE + ((size_t)(b * SEQ + t)) * DM + h * 128 + (lane & 15) * 8), (LAS unsigned*)(lds + L_RAW + qq * 1024), 16, 0, 0); } } } while (0)
        LRU_DMA_ROWS(d ? NCHK - 1 : 0);
        asm volatile("s_waitcnt vmcnt(0)" ::: "memory");
        __syncthreads();
        float S = 0.f;
        for (int ci = 0; ci < NCHK; ++ci) {
            const int c = d ? NCHK - 1 - ci : ci;
            if (ci == NCHK / 2) lru_mid_barrier(p.ws, lds, wv);
            const bool comb = ci >= NCHK / 2;
            float wcv[8]; const bool wc_on = widx < WC_END; WcItem wt{};
            if (wc_on) { wt = wconv_decode(p, widx, lane); wconv_load(wt, wcv); }
            u32x4 ph[2], gt[2];
            if (comb) {
#pragma unroll
                for (int tt = 0; tt < 2; ++tt) { const size_t o = ((size_t)(b * SEQ + c * TL + lt0 + tt)) * DM + h * 128 + cv * 8; ph[tt] = __builtin_nontemporal_load((const u32x4*)(HP + o)); gt[tt] = __builtin_nontemporal_load((const u32x4*)(GATE + o)); }
            }
            {
                u32x4 rw[5];
#pragma unroll
                for (int i = 0; i < 5; ++i) { const int t = c * TL + lt0 - 2 + i; const u32x4 v = *(const LAS u32x4*)(lds + L_RAW + (lt0 + i) * 256 + cv * 16);
                    rw[i] = (t >= 0 && t < SEQ) ? v : (u32x4){0u, 0u, 0u, 0u}; }
                f32x4 wv[5][2];
#pragma unroll
                for (int tap = 0; tap < 5; ++tap) { wv[tap][0] = *(const LAS f32x4*)(cw + tap * 128 + cv * 8); wv[tap][1] = *(const LAS f32x4*)(cw + tap * 128 + cv * 8 + 4); }
                u32x4 o0, o1;
#pragma unroll
                for (int e = 0; e < 4; ++e) {
                    f32x2 W[5], X[5];
#pragma unroll
                    for (int tap = 0; tap < 5; ++tap) W[tap] = (f32x2){wv[tap][e >> 1][(2 * e) & 3], wv[tap][e >> 1][(2 * e + 1) & 3]};
#pragma unroll
                    for (int i = 0; i < 5; ++i) X[i] = (f32x2){bflo(rw[i][e]), bfhi(rw[i][e])};
                    f32x2 a0 = W[4], a1 = W[4];
                    a0 = W[0] * X[0] + a0; a0 = W[1] * X[1] + a0; a0 = W[2] * X[2] + a0; a0 = W[3] * X[3] + a0;
                    a1 = W[0] * X[1] + a1; a1 = W[1] * X[2] + a1; a1 = W[2] * X[3] + a1; a1 = W[3] * X[4] + a1;
                    o0[e] = pk2(a0.x, a0.y); o1[e] = pk2(a1.x, a1.y);
                }
                *(LAS u32x4*)(lds + L_A + lt0 * A_PITCH + cv * 16) = o0;
                *(LAS u32x4*)(lds + L_A + (lt0 + 1) * A_PITCH + cv * 16) = o1;
            }
            __syncthreads();
            if (ci + 1 < NCHK) LRU_DMA_ROWS(d ? c - 1 : c + 1);
            f32x4 av[4], uv[4];
#pragma unroll
            for (int m = 0; m < 4; ++m) { av[m] = (f32x4){0.f, 0.f, 0.f, 0.f}; uv[m] = (f32x4){0.f, 0.f, 0.f, 0.f}; }
#pragma unroll
            for (int m = 0; m < 4; ++m)
#pragma unroll
                for (int kk = 0; kk < 4; ++kk) {
                    const bf16x8 a = *(const LAS bf16x8*)(lds + L_A + (m * 16 + fr) * A_PITCH + (kk * 32 + fq * 8) * 2);
                    av[m] = __builtin_amdgcn_mfma_f32_16x16x32_bf16(a, bfr[0][kk], av[m], 0, 0, 0);
                    uv[m] = __builtin_amdgcn_mfma_f32_16x16x32_bf16(a, bfr[1][kk], uv[m], 0, 0, 0);
                }
#pragma unroll
            for (int m = 0; m < 4; ++m)
#pragma unroll
                for (int jp = 0; jp < 4; jp += 2) {
                    const int tok = m * 16 + fq * 4 + jp;
                    f32x2 x;
                    x.x = __uint_as_float((unsigned)(*(const LAS unsigned short*)(lds + L_A + tok * A_PITCH + chl * 2)) << 16);
                    x.y = __uint_as_float((unsigned)(*(const LAS unsigned short*)(lds + L_A + (tok + 1) * A_PITCH + chl * 2)) << 16);
                    const f32x2 zr = {av[m][jp], av[m][jp + 1]}, zi = {uv[m][jp], uv[m][jp + 1]};
                    f32x2 ar = zr * (-1.4426950408889634f) + nba, ai_ = zi * (-1.4426950408889634f) + nbx;
                    ar = __builtin_elementwise_min(ar, (f32x2){80.f, 80.f}); ai_ = __builtin_elementwise_min(ai_, (f32x2){80.f, 80.f});
                    f32x2 e1, e2; e1.x = __builtin_amdgcn_exp2f(ar.x); e1.y = __builtin_amdgcn_exp2f(ar.y); e2.x = __builtin_amdgcn_exp2f(ai_.x); e2.y = __builtin_amdgcn_exp2f(ai_.y);
                    const f32x2 d1 = e1 + 1.f, d2 = e2 + 1.f, pr = d1 * d2;
                    f32x2 R; R.x = __builtin_amdgcn_rcpf(pr.x); R.y = __builtin_amdgcn_rcpf(pr.y);
                    const f32x2 r = R * d2, ig = R * d1;
                    const f32x2 la = r * clu;
                    f32x2 pq = la * 0.0001984127f + 0.0013888889f; pq = pq * la + 0.0083333338f; pq = pq * la + 0.041666668f; pq = pq * la + 0.16666667f; pq = pq * la + 0.5f; pq = pq * la + 1.f;
                    const f32x2 q = -(la * pq);
                    const f32x2 s2 = q * (2.f - q);
                    f32x2 mult; mult.x = __builtin_amdgcn_sqrtf(fmaxf(s2.x, 0.f)); mult.y = __builtin_amdgcn_sqrtf(fmaxf(s2.y, 0.f));
                    const f32x2 an = 1.f - q, un = mult * (ig * x);
                    av[m][jp] = an.x; av[m][jp + 1] = an.y; uv[m][jp] = un.x; uv[m][jp + 1] = un.y;
                }
            if (d == 0) lru_scan<false>(av, uv, S, fr, fq); else lru_scan<true>(av, uv, S, fr, fq);
#pragma unroll
            for (int m = 0; m < 4; ++m)
#pragma unroll
                for (int j = 0; j < 4; ++j) hbuf[(m * 16 + fq * 4 + j) * H_PITCH + chl] = uv[m][j];
            asm volatile("s_waitcnt vmcnt(0)" ::: "memory");
            __syncthreads();
#pragma unroll
            for (int tt = 0; tt < 2; ++tt) {
                const LAS float* hp = hbuf + (lt0 + tt) * H_PITCH + cv * 8;
                const f32x4 f0 = *(const LAS f32x4*)hp, f1 = *(const LAS f32x4*)(hp + 4);
                u32x4 w; const size_t o = ((size_t)(b * SEQ + c * TL + lt0 + tt)) * DM + h * 128 + cv * 8;
                if (!comb) { w.x = pk2(f0[0], f0[1]); w.y = pk2(f0[2], f0[3]); w.z = pk2(f1[0], f1[1]); w.w = pk2(f1[2], f1[3]); *(u32x4*)(HD + o) = w; }
                else {
                    const u32x4 q = ph[tt], g = gt[tt];
                    w.x = pk2((f0[0] + bflo(q.x)) * bflo(g.x), (f0[1] + bfhi(q.x)) * bfhi(g.x)); w.y = pk2((f0[2] + bflo(q.y)) * bflo(g.y), (f0[3] + bfhi(q.y)) * bfhi(g.y));
                    w.z = pk2((f1[0] + bflo(q.z)) * bflo(g.z), (f1[1] + bfhi(q.z)) * bfhi(g.z)); w.w = pk2((f1[2] + bflo(q.w)) * bflo(g.w), (f1[3] + bfhi(q.w)) * bfhi(g.w));
                    *(u32x4*)(Y + o) = w; }
            }
            if (wc_on) { wconv_store(wt, wcv); widx += ngw;
            }
        }
#undef LRU_DMA_ROWS
    }
    for (; widx < WC_END; widx += ngw) { const WcItem wt2 = wconv_decode(p, widx, lane); float v[8]; wconv_load(wt2, v); wconv_store(wt2, v); }
}
__device__ __forceinline__ void ycomb_phase(const P& p, int wv) {
    const u32x4* HF = (const u32x4*)(p.ws + WS_HF); const u32x4* HB = (const u32x4*)(p.ws + WS_HB); const u32x4* GT = (const u32x4*)(p.ws + WS_GATE);
    u32x4* Y = (u32x4*)(p.ws + WS_Y);
    const size_t n = (size_t)MTOK * DM / 8, stride = (size_t)gridDim.x * NTHREADS;
    for (size_t i = (size_t)lbid() * NTHREADS + ltid(wv); i < n; i += 4 * stride) {
        u32x4 f[4], k[4], g[4];
#pragma unroll
        for (int u = 0; u < 4; ++u) { const size_t ii = i + u * stride; if (ii < n) { f[u] = HF[ii]; k[u] = HB[ii]; g[u] = GT[ii]; } }
#pragma unroll
        for (int u = 0; u < 4; ++u) { const size_t ii = i + u * stride; if (ii < n) { u32x4 w;
#pragma unroll
            for (int e = 0; e < 4; ++e) w[e] = pk2((bflo(f[u][e]) + bflo(k[u][e])) * bflo(g[u][e]), (bfhi(f[u][e]) + bfhi(k[u][e])) * bfhi(g[u][e]));
            Y[ii] = w; } }
    }
}

__device__ __forceinline__ u32x4 rope_chunk(u32x4 w, const float (&g)[8], const float (&cs)[8], const float (&sn)[8]) {
    float v[8] = {bflo(w.x), bfhi(w.x), bflo(w.y), bfhi(w.y), bflo(w.z), bfhi(w.z), bflo(w.w), bfhi(w.w)};
    float ss = 0.f;
#pragma unroll
    for (int e = 0; e < 8; ++e) ss += v[e] * v[e];
    ss += lane_xor<1>(ss); ss += lane_xor<2>(ss); ss += lane_xor<4>(ss); ss += lane_xor<8>(ss);
    const float rs = rsqrtf(ss * (1.f / 128.f) + EPS);
    float o[8];
#pragma unroll
    for (int e = 0; e < 8; ++e) { const float y = v[e] * rs * g[e]; const float py = lane_xor<4>(y); o[e] = y * cs[e] + py * sn[e]; }
    u32x4 r; r.x = pk2(o[0], o[1]); r.y = pk2(o[2], o[3]); r.z = pk2(o[4], o[5]); r.w = pk2(o[6], o[7]);
    return r;
}
__device__ __forceinline__ void rope_phase(const P& p, int wave, int lane, bool dry) {
    bf16_t* Q = (bf16_t*)(p.ws + WS_Q); bf16_t* Kb = (bf16_t*)(p.ws + WS_K);
    bf16_t* Qo = dry ? (bf16_t*)(p.ws + WS_HB) : Q; bf16_t* Ko = dry ? (bf16_t*)(p.ws + WS_HB) : Kb;
    const int gw = lbid() * NWAVES + wave, ngw = gridDim.x * NWAVES;
    const int j = lane & 15, hs = lane >> 4;
    float gq[8], gk[8], inv[8];
#pragma unroll
    for (int e = 0; e < 8; ++e) { gq[e] = p.in[I_QG][8 * j + e]; gk[e] = p.in[I_KG][8 * j + e]; inv[e] = exp2f(-(float)(8 * (j & 3) + e) * (13.287712379549449f / 32.f)) * 0.15915494309189535f; }
    const float sgn = (j & 4) ? 1.f : -1.f;
    for (int tk = 2 * gw; tk < MTOK; tk += 2 * ngw) {
        u32x4 qa[2], qb[2], kk[2];
#pragma unroll
        for (int u = 0; u < 2; ++u) { const size_t tok = tk + u;
            qa[u] = *(const u32x4*)(Q + tok * DM + hs * 128 + j * 8); qb[u] = *(const u32x4*)(Q + tok * DM + 512 + hs * 128 + j * 8);
            kk[u] = *(const u32x4*)(Kb + tok * NKV + (hs & 1) * 128 + j * 8); }
#pragma unroll
        for (int u = 0; u < 2; ++u) { const size_t tok = tk + u; const int t = (int)tok & (SEQ - 1);
            const float pos = (float)(j < 8 ? (t >> 6) : (t & 63));
            float cs[8], sn[8];
#pragma unroll
            for (int e = 0; e < 8; ++e) { const float a = pos * inv[e]; cs[e] = __builtin_amdgcn_cosf(a); sn[e] = sgn * __builtin_amdgcn_sinf(a); }
            const u32x4 ra = rope_chunk(qa[u], gq, cs, sn), rb = rope_chunk(qb[u], gq, cs, sn), rk = rope_chunk(kk[u], gk, cs, sn);
            *(u32x4*)(Qo + tok * DM + hs * 128 + j * 8) = ra; *(u32x4*)(Qo + tok * DM + 512 + hs * 128 + j * 8) = rb;
            if (hs < 2) *(u32x4*)(Ko + tok * NKV + hs * 128 + j * 8) = rk; }
    }
}

__device__ __forceinline__ void rope_tile(bf16_t* base, int ld, int tok0, const float* g, int wave, int lane) {
    const int j = lane & 15, hs = lane >> 4, rr = hs >> 1, hh = hs & 1;
    float g8[8], inv[8];
#pragma unroll
    for (int e = 0; e < 8; ++e) { g8[e] = g[8 * j + e]; inv[e] = exp2f(-(float)(8 * (j & 3) + e) * (13.287712379549449f / 32.f)) * 0.15915494309189535f; }
    const float sgn = (j & 4) ? 1.f : -1.f;
    for (int it = 0; it < 16; it += 8) {
        u32x4 w[8];
#pragma unroll
        for (int u = 0; u < 8; ++u) { const int r = wave * 32 + (it + u) * 2 + rr; w[u] = *(const u32x4*)(base + (size_t)r * ld + hh * 128 + j * 8); }
#pragma unroll
        for (int u = 0; u < 8; ++u) { const int r = wave * 32 + (it + u) * 2 + rr; const int t = (tok0 + r) & (SEQ - 1);
            const float pos = (float)(j < 8 ? (t >> 6) : (t & 63));
            float cs[8], sn[8];
#pragma unroll
            for (int e = 0; e < 8; ++e) { const float a = pos * inv[e]; cs[e] = __builtin_amdgcn_cosf(a); sn[e] = sgn * __builtin_amdgcn_sinf(a); }
            *(u32x4*)(base + (size_t)r * ld + hh * 128 + j * 8) = rope_chunk(w[u], g8, cs, sn); }
    }
}

namespace attn {
constexpr int D = 128, NW = 8, QBLK = 32, KVBLK = 64;
constexpr float SCALE = 0.088388347648318440f;
constexpr float THR = 8.f;
constexpr int LDQ = DM, LDK = NKV, LDO = DM;
constexpr size_t SHM_V = KVBLK * D * 2, SHM_K = KVBLK * D * 2, SHM_ATTN = 2 * SHM_V + 2 * SHM_K + NW * 64 * 4;
#define KSWZ(row, colB) ((row) * 256 + ((colB) ^ (((row) & 7) << 4)))
#define SBAR() __builtin_amdgcn_sched_barrier(0)
__device__ __forceinline__ int crow(int r, int hi) { return (r & 3) + 8 * (r >> 2) + 4 * hi; }
__device__ __forceinline__ unsigned cvtpk(float lo, float hi) { unsigned r; asm volatile("v_cvt_pk_bf16_f32 %0, %1, %2" : "=v"(r) : "v"(lo), "v"(hi)); return r; }
__device__ __forceinline__ void partialSM(f32x16& p0, f32x16& p1, float& m_reg, float& mn, float& alpha) {
    constexpr float C = SCALE * 1.4426950408889634f;
    float pmax = p0[0]; for (int r = 1; r < 16; ++r) pmax = fmaxf(pmax, p0[r]); for (int r = 0; r < 16; ++r) pmax = fmaxf(pmax, p1[r]);
    { auto rr = __builtin_amdgcn_permlane32_swap(__float_as_uint(pmax), __float_as_uint(pmax), false, false);
      pmax = fmaxf(__uint_as_float(rr[0]), __uint_as_float(rr[1])); }
    if (__builtin_expect(__all(pmax - m_reg <= THR / SCALE), 1)) { mn = m_reg; alpha = 1.f; }
    else { mn = fmaxf(m_reg, pmax); alpha = __builtin_amdgcn_exp2f((m_reg - mn) * C); m_reg = mn; }
    float mnC = -mn * C;
    for (int r = 0; r < 16; ++r) p0[r] = fmaf(p0[r], C, mnC); for (int r = 0; r < 16; ++r) p1[r] = fmaf(p1[r], C, mnC);
    for (int r = 0; r < 16; ++r) p0[r] = __builtin_amdgcn_exp2f(p0[r]);
}
__device__ __forceinline__ void finishSM(f32x16& p0, f32x16& p1, float alpha, float& l_reg, bf16x8& pa0, bf16x8& pa1, bf16x8& pa2, bf16x8& pa3) {
    for (int r = 0; r < 16; ++r) p1[r] = __builtin_amdgcn_exp2f(p1[r]);
    float ps = 0; for (int r = 0; r < 16; ++r) ps += p0[r]; for (int r = 0; r < 16; ++r) ps += p1[r];
    { auto rr = __builtin_amdgcn_permlane32_swap(__float_as_uint(ps), __float_as_uint(ps), false, false);
      ps = __uint_as_float(rr[0]) + __uint_as_float(rr[1]); }
    l_reg = l_reg * alpha + ps;
#define PK4(P, BASE, OUT) do { unsigned a0 = cvtpk(P[BASE + 0], P[BASE + 1]), a1 = cvtpk(P[BASE + 2], P[BASE + 3]);   \
    unsigned b0 = cvtpk(P[BASE + 4], P[BASE + 5]), b1 = cvtpk(P[BASE + 6], P[BASE + 7]);                              \
    auto r0 = __builtin_amdgcn_permlane32_swap(a0, b0, false, false); auto r1 = __builtin_amdgcn_permlane32_swap(a1, b1, false, false); \
    u32x4 w = {r0[0], r1[0], r0[1], r1[1]}; OUT = *reinterpret_cast<bf16x8*>(&w); } while (0)
    PK4(p0, 0, pa0); PK4(p0, 8, pa1); PK4(p1, 0, pa2); PK4(p1, 8, pa3);
#undef PK4
}
__device__ __forceinline__ void qkt(f32x16& p0, f32x16& p1, const bf16_t* Ks, const bf16x8* qr, int r32, int hi) {
    p0 = f32x16{}; p1 = f32x16{};
    for (int d0 = 0; d0 < 8; ++d0) { int cb = (d0 * 16 + hi * 8) * 2;
        bf16x8 b0 = *reinterpret_cast<const bf16x8*>((const char*)Ks + KSWZ(r32, cb));
        bf16x8 b1 = *reinterpret_cast<const bf16x8*>((const char*)Ks + KSWZ(32 + r32, cb));
        p0 = __builtin_amdgcn_mfma_f32_32x32x16_bf16(b0, qr[d0], p0, 0, 0, 0);
        p1 = __builtin_amdgcn_mfma_f32_32x32x16_bf16(b1, qr[d0], p1, 0, 0, 0); }
}
__device__ __forceinline__ int v_st(int k, int c) { const int kk = (k & ~0xC) | ((k & 4) << 1) | ((k & 8) >> 1); return ((kk >> 3) * 4 + (c >> 5)) * 512 + ((kk & 7) * 32 + (c & 31)) * 2; }
__device__ __forceinline__ int v_rd_base(int lane) { return ((lane & 3) << 3) | (((lane >> 2) & 3) << 6) | (((lane >> 4) & 1) << 5) | (((lane >> 5) & 1) << 8); }
constexpr int v_rd_off(int d0, int ks, int half) { return d0 * 512 + ks * 4096 + half * 2048; }
template <int OFF> __device__ __forceinline__ s16x4 tr_read(int vb) {
    s16x4 r; asm volatile("ds_read_b64_tr_b16 %0, %1 offset:%2" : "=&v"(r) : "v"(vb), "i"(OFF) : "memory"); return r;
}
template <int D0> __device__ __forceinline__ void pv_one(f32x16& od, int vb, bf16x8 pa0, bf16x8 pa1, bf16x8 pa2, bf16x8 pa3) {
    const s16x4 l0 = tr_read<v_rd_off(D0, 0, 0)>(vb), h0 = tr_read<v_rd_off(D0, 0, 1)>(vb), l1 = tr_read<v_rd_off(D0, 1, 0)>(vb), h1 = tr_read<v_rd_off(D0, 1, 1)>(vb);
    const s16x4 l2 = tr_read<v_rd_off(D0, 2, 0)>(vb), h2 = tr_read<v_rd_off(D0, 2, 1)>(vb), l3 = tr_read<v_rd_off(D0, 3, 0)>(vb), h3 = tr_read<v_rd_off(D0, 3, 1)>(vb);
    asm volatile("s_waitcnt lgkmcnt(0)" ::: "memory"); SBAR();
#define PK(L, H) (bf16x8){L[0], L[1], L[2], L[3], H[0], H[1], H[2], H[3]}
    od = __builtin_amdgcn_mfma_f32_32x32x16_bf16(pa0, PK(l0, h0), od, 0, 0, 0);
    od = __builtin_amdgcn_mfma_f32_32x32x16_bf16(pa1, PK(l1, h1), od, 0, 0, 0);
    od = __builtin_amdgcn_mfma_f32_32x32x16_bf16(pa2, PK(l2, h2), od, 0, 0, 0);
    od = __builtin_amdgcn_mfma_f32_32x32x16_bf16(pa3, PK(l3, h3), od, 0, 0, 0);
#undef PK
}
__device__ __forceinline__ void pv_d0(f32x16* o, int vb, bf16x8 pa0, bf16x8 pa1, bf16x8 pa2, bf16x8 pa3) {
    pv_one<0>(o[0], vb, pa0, pa1, pa2, pa3); pv_one<1>(o[1], vb, pa0, pa1, pa2, pa3); pv_one<2>(o[2], vb, pa0, pa1, pa2, pa3); pv_one<3>(o[3], vb, pa0, pa1, pa2, pa3);
}
__device__ __forceinline__ void attn_dense_body(const bf16_t* Qb, const bf16_t* __restrict__ Kh, const bf16_t* __restrict__ Vh,
                                                bf16_t* Ob, int seq, char* lds, int wv, const float* qg, int t0) {
    const int tid = ltid(wv), wid = tid >> 6, lane = tid & 63, r32 = lane & 31, hi = lane >> 5;
    bf16_t* V_lds = (bf16_t*)lds; bf16_t* K_lds = (bf16_t*)(lds + 2 * SHM_V);
    float* ws = (float*)(lds + 2 * SHM_V + 2 * SHM_K) + wid * 64; float* li_l = ws; float* al_l = ws + 32;
    float m_reg = -1e30f, l_reg = 0; f32x16 o[4] = {}; bf16x8 qr[8];
    const bf16_t* Qw = Qb + (long)(wid * QBLK + r32) * LDQ + hi * 8;
#pragma unroll
    for (int d0 = 0; d0 < 8; ++d0) qr[d0] = __builtin_nontemporal_load(reinterpret_cast<const bf16x8*>(Qw + d0 * 16));
    {
        float ss = 0.f;
#pragma unroll
        for (int d0 = 0; d0 < 8; ++d0) { const u32x4 w = *reinterpret_cast<const u32x4*>(&qr[d0]);
#pragma unroll
            for (int e = 0; e < 4; ++e) { const float lo = bflo(w[e]), hi_ = bfhi(w[e]); ss += lo * lo + hi_ * hi_; } }
        ss = sum_xor32(ss);
        const float rs = rsqrtf(ss * (1.f / 128.f) + EPS);
        const int t = t0 + wid * QBLK + r32;
#pragma unroll
        for (int a = 0; a < 2; ++a) {
            const float pos = (float)(a ? (t & 63) : (t >> 6));
#pragma unroll
            for (int j = 0; j < 2; ++j) {
                const int c1 = 4 * a + j, c2 = c1 + 2;
                const u32x4 w1 = *reinterpret_cast<const u32x4*>(&qr[c1]), w2 = *reinterpret_cast<const u32x4*>(&qr[c2]);
                const f32x4 g1a = *(const f32x4*)(qg + c1 * 16 + hi * 8), g1b = *(const f32x4*)(qg + c1 * 16 + hi * 8 + 4), g2a = *(const f32x4*)(qg + c2 * 16 + hi * 8), g2b = *(const f32x4*)(qg + c2 * 16 + hi * 8 + 4);
                float o1[8], o2[8];
#pragma unroll
                for (int e = 0; e < 8; ++e) {
                    const float x1 = (e & 1) ? bfhi(w1[e >> 1]) : bflo(w1[e >> 1]), x2 = (e & 1) ? bfhi(w2[e >> 1]) : bflo(w2[e >> 1]);
                    const float g1 = e < 4 ? g1a[e & 3] : g1b[e & 3], g2 = e < 4 ? g2a[e & 3] : g2b[e & 3];
                    const float ang = pos * (exp2f(-(float)(j * 16 + hi * 8 + e) * (13.287712379549449f / 32.f)) * 0.15915494309189535f);
                    const float cs = __builtin_amdgcn_cosf(ang), sn = __builtin_amdgcn_sinf(ang);
                    const float y1 = x1 * rs * g1, y2 = x2 * rs * g2;
                    o1[e] = y1 * cs - y2 * sn; o2[e] = y2 * cs + y1 * sn;
                }
                u32x4 p1, p2;
#pragma unroll
                for (int e = 0; e < 4; ++e) { p1[e] = cvtpk(o1[2 * e], o1[2 * e + 1]); p2[e] = cvtpk(o2[2 * e], o2[2 * e + 1]); }
                qr[c1] = *reinterpret_cast<const bf16x8*>(&p1); qr[c2] = *reinterpret_cast<const bf16x8*>(&p2);
            }
        }
    }
    const int sr = tid >> 4, sc = (tid & 15) * 8, vst0 = v_st(sr, sc), vst1 = v_st(32 + sr, sc);
    const int vb0 = (int)(uintptr_t)V_lds + v_rd_base(lane);
    struct { bf16x8 vs0, vs1, ks0, ks1; } sr_[2];
#define LD8(p) (*reinterpret_cast<const bf16x8*>(p))
#define SLOAD(i, k0) do { sr_[i].vs0 = LD8(&Vh[(long)((k0) + sr) * LDK + sc]); sr_[i].vs1 = LD8(&Vh[(long)((k0) + 32 + sr) * LDK + sc]); \
    sr_[i].ks0 = LD8(&Kh[(long)((k0) + sr) * LDK + sc]); sr_[i].ks1 = LD8(&Kh[(long)((k0) + 32 + sr) * LDK + sc]); } while (0)
#define SWRITE(b, i) do { *(bf16x8*)((char*)V_lds + (b) * SHM_V + vst0) = sr_[i].vs0;          \
    *(bf16x8*)((char*)V_lds + (b) * SHM_V + vst1) = sr_[i].vs1; int kc = sc * 2;               \
    *(bf16x8*)((char*)K_lds + (b) * SHM_K + KSWZ(sr, kc)) = sr_[i].ks0;                       \
    *(bf16x8*)((char*)K_lds + (b) * SHM_K + KSWZ(32 + sr, kc)) = sr_[i].ks1; } while (0)
#define SWAIT() asm volatile("s_waitcnt vmcnt(4)" ::: "memory")
#define RESC(a) do { if (__any((a) < 1.f)) { if (hi == 0) al_l[r32] = (a); asm volatile("s_waitcnt lgkmcnt(0)" ::: "memory"); \
    for (int d = 0; d < 4; ++d) for (int r = 0; r < 16; ++r) o[d][r] *= al_l[crow(r, hi)]; } } while (0)
    f32x16 pA0, pA1, pB0, pB1; float mnA, mnB, alA, alB; bf16x8 pa0, pa1, pa2, pa3; const int NT = seq / KVBLK;
    constexpr int SE = 0, SO = 1;
    SLOAD(SE, 0); asm volatile("s_waitcnt vmcnt(0)" ::: "memory"); SWRITE(0, SE); __syncthreads();
    qkt(pA0, pA1, K_lds, qr, r32, hi); partialSM(pA0, pA1, m_reg, mnA, alA);
    SLOAD(SO, KVBLK); if (2 < NT) SLOAD(SE, 2 * KVBLK);
    SWAIT(); SWRITE(1, SO); __syncthreads();
    for (int j = 1; j + 1 < NT; j += 2) {
        SBAR(); qkt(pB0, pB1, (bf16_t*)((char*)K_lds + SHM_K), qr, r32, hi);
        finishSM(pA0, pA1, alA, l_reg, pa0, pa1, pa2, pa3); SBAR();
        SLOAD(SO, (j + 2) * KVBLK); SBAR();
        pv_d0(o, vb0, pa0, pa1, pa2, pa3); partialSM(pB0, pB1, m_reg, mnB, alB);
        __syncthreads(); SWAIT(); SWRITE(0, SE);
        RESC(alB); __syncthreads();
        SBAR(); qkt(pA0, pA1, K_lds, qr, r32, hi);
        finishSM(pB0, pB1, alB, l_reg, pa0, pa1, pa2, pa3); SBAR();
        if (j + 3 < NT) SLOAD(SE, (j + 3) * KVBLK); SBAR();
        pv_d0(o, vb0 + (int)SHM_V, pa0, pa1, pa2, pa3); partialSM(pA0, pA1, m_reg, mnA, alA);
        __syncthreads(); SWAIT(); SWRITE(1, SO);
        RESC(alA); __syncthreads();
    }
    SBAR(); qkt(pB0, pB1, (bf16_t*)((char*)K_lds + SHM_K), qr, r32, hi);
    finishSM(pA0, pA1, alA, l_reg, pa0, pa1, pa2, pa3); SBAR();
    pv_d0(o, vb0, pa0, pa1, pa2, pa3); partialSM(pB0, pB1, m_reg, mnB, alB);
    __syncthreads(); RESC(alB);
    finishSM(pB0, pB1, alB, l_reg, pa0, pa1, pa2, pa3); SBAR();
    pv_d0(o, vb0 + (int)SHM_V, pa0, pa1, pa2, pa3);
    if (hi == 0) li_l[r32] = l_reg; asm volatile("s_waitcnt lgkmcnt(0)" ::: "memory");
    float rli[16];
#pragma unroll
    for (int r = 0; r < 16; ++r) rli[r] = __builtin_amdgcn_rcpf(li_l[crow(r, hi)]);
    bf16_t* Ow = Ob + (long)(wid * QBLK) * LDO;
    const int odd = lane & 1;
#pragma unroll
    for (int r = 0; r < 16; r += 2) {
#pragma unroll
        for (int d0 = 0; d0 < 4; ++d0) {
            const float m0 = o[d0][r] * rli[r], m1 = o[d0][r + 1] * rli[r + 1];
            const float snd = odd ? m0 : m1;
            const float rcv = lane_xor<1>(snd);
            const unsigned w = odd ? cvtpk(rcv, m1) : cvtpk(m0, rcv);
            const int orow = crow(odd ? r + 1 : r, hi);
            *(unsigned*)(Ow + (long)orow * LDO + d0 * 32 + (r32 & ~1)) = w;
        }
    }
#undef LD8
#undef SLOAD
#undef SWRITE
#undef SWAIT
#undef RESC
}
}

__device__ __forceinline__ void attn_phase(const P& p, char* lds, bool dry, int wv) {
    const bf16_t* Q = (const bf16_t*)(p.ws + WS_Q); const bf16_t* Kb = (const bf16_t*)(p.ws + WS_K); const bf16_t* Vb = (const bf16_t*)(p.ws + WS_V);
    bf16_t* O = (bf16_t*)(p.ws + (dry ? WS_HB : WS_Q));
    const int G = gridDim.x, bx = lbid();
    const int vcu = (G % 8 == 0) ? (bx % 8) * (G / 8) + bx / 8 : bx;
    for (int it = vcu; it < BATCH * 8 * 8; it += G) {
        const int grp = it >> 5, within = it & 31, b = grp >> 1, kvh = grp & 1, h = kvh * 4 + (within >> 3), qb = within & 7;
        __syncthreads();
        attn::attn_dense_body(Q + ((size_t)(b * SEQ + qb * 256)) * DM + h * 128, Kb + (size_t)b * SEQ * NKV + kvh * 128, Vb + (size_t)b * SEQ * NKV + kvh * 128,
                              O + ((size_t)(b * SEQ + qb * 256)) * DM + h * 128, SEQ, lds, wv, p.in[I_QG], qb * 256);
    }
    __syncthreads();
}

constexpr int NPHASE = 14;
#ifndef ONLY
#define ONLY -1
#endif
#ifndef ENMASK
#define ENMASK 0x3fff
#endif
#ifndef REPMASK
#define REPMASK 0
#endif
#define EN(k) ((ONLY < 0 || ONLY == (k)) && ((ENMASK >> (k)) & 1))
typedef const __attribute__((address_space(4))) P* KP;
__device__ __forceinline__ P load_params() {
#if defined(__HIP_DEVICE_COMPILE__)
    KP kp = (KP)__builtin_amdgcn_kernarg_segment_ptr();
    asm volatile("" : "+s"(kp));
    return *kp;
#else
    return P{};
#endif
}
__global__ void __launch_bounds__(NTHREADS) mega(P parg) {
    extern __shared__ __attribute__((aligned(16))) unsigned char shm[];
    LAS unsigned char* lds = (LAS unsigned char*)shm;
    cg::grid_group grid = cg::this_grid();
    const int ph_lo = parg.ph_lo, ph_hi = parg.ph_hi;
    const int wv0 = __builtin_amdgcn_readfirstlane((int)threadIdx.x >> 6);
    if (ph_hi - ph_lo > 1) {
        volatile LAS unsigned* st = (volatile LAS unsigned*)(lds + LDS_MAIN);
        if (threadIdx.x == 0) { st[0] = 0u; st[1] = 0u; }
        __syncthreads();
        (void)xcd_barrier_post((unsigned*)(load_params().ws + WS_BAR), st);
    }
    int nseam = 0;
    for (int ph2 = 2 * ph_lo; ph2 < 2 * ph_hi; ++ph2) {
        const int ph = ph2 >> 1; const bool dry = (ph2 & 1);
        if (ph == 8 || ph == 3) continue;
        if ((ph2 & 1) && !((REPMASK >> ph) & 1)) continue;
#define WL() const int tid = ltid(wv0), wave = __builtin_amdgcn_readfirstlane(tid >> 6), lane = tid & 63; (void)lane; (void)wave
#define GW() const int gw = lbid() * NWAVES + wave, ngw = gridDim.x * NWAVES
        switch (ph) {
        case 0: if (EN(0)) { const P p = load_params(); WL(); prep_phase(p, lds, wave, lane); } break;
        case 1: if (EN(1)) { const P p = load_params(); unsigned char* ws = p.ws;
                  pg8::Gemm g{(const bf16_t*)(ws + WS_HN), (const bf16_t*)(ws + WS_WIN), MTOK, 2 * DM, DM}; pg8::StaticOrder S; S.init(MTOK, 2 * DM, gridDim.x, lbid());
                  pg8::EpiWin E{(bf16_t*)(ws + WS_GATE), (bf16_t*)(ws + WS_RECPRE), (const float*)(ws + WS_PART)}; pg8::gemm_phase(lds, g, S, E, wv0); } break;
        case 2: if (EN(2)) { const P p = load_params(); lru_phase(p, lds, wv0); } break;
        case 3: if (EN(3)) { const P p = load_params(); ycomb_phase(p, wv0); } break;
        case 4: case 6: case 10: case 12: if (EN(4)) {
            const P p = load_params(); unsigned char* ws = p.ws;
            const bf16_t* A = (const bf16_t*)(ws + (ph == 4 ? WS_Y : (ph == 10 ? WS_Q : WS_U)));
            const bf16_t* Bt = (const bf16_t*)(ws + (ph == 4 ? WS_WOUT : ph == 6 ? WS_WDN0 : ph == 10 ? WS_WO : WS_WDN1));
            const int K = (ph == 6 || ph == 12) ? DFF : DM;
            pg8::Gemm g{A, Bt, MTOK, DM, K}; pg8::StaticOrder S; S.init(MTOK, DM, gridDim.x, lbid());
            pg8::EpiResid E{(bf16_t*)(ws + (dry ? WS_HB : WS_HN)), (float*)(ws + (dry ? WS_HB : WS_PART)), ph != 12}; pg8::gemm_phase(lds, g, S, E, wv0); } break;
        case 5: case 11: if (EN(5)) {
            const P p = load_params(); unsigned char* ws = p.ws;
            pg8::Gemm g{(const bf16_t*)(ws + WS_HN), (const bf16_t*)(ws + (ph == 5 ? WS_WUP0 : WS_WUP1)), MTOK, DFF, DM}; pg8::StaticOrder S; S.init(MTOK, DFF, gridDim.x, lbid());
            pg8::EpiRelu2 E{(bf16_t*)(ws + WS_U), (const float*)(ws + WS_PART)}; pg8::gemm_phase(lds, g, S, E, wv0); } break;
        case 7: if (EN(7)) { const P p = load_params(); unsigned char* ws = p.ws;
                  pg8::Gemm g{(const bf16_t*)(ws + WS_HN), (const bf16_t*)(ws + WS_WQKV), MTOK, NQKV, DM}; pg8::StaticOrder S; S.init(MTOK, NQKV, gridDim.x, lbid());
                  pg8::EpiQKV E{ws, (const float*)(ws + WS_PART)}; pg8::gemm_phase(lds, g, S, E, wv0);
                  asm volatile("s_waitcnt vmcnt(0)" ::: "memory"); __syncthreads(); __builtin_amdgcn_fence(__ATOMIC_ACQUIRE, "agent"); asm volatile("s_waitcnt vmcnt(0)" ::: "memory");
                  pg8::Unit u; WL();
                  for (int i = 0; S.next(i, u); ++i) { if (u.pn == 4)
                          rope_tile((bf16_t*)(ws + WS_K) + (size_t)u.pm * 256 * NKV, NKV, u.pm * 256, p.in[I_KG], wave, lane); } } break;
        case 8: if (EN(8)) { const P p = load_params(); WL(); rope_phase(p, wave, lane, dry); } break;
        case 9: if (EN(9)) { const P p = load_params(); attn_phase(p, (char*)shm, dry, wv0); } break;
        case 13: if (EN(13)) { const P p = load_params(); WL(); GW(); final_norm_rows((const bf16_t*)(p.ws + WS_HN), p.in[I_FG], p.out, gw, ngw, lane); } break;
        default: break;
        }
        if ((((ph2 & 1) == 0) && ((REPMASK >> ph) & 1)) || ph + 1 < ph_hi) { if (ph_hi < 0) grid.sync();   { XcdBarrier xb2; xb2.bar = (unsigned*)(load_params().ws + WS_BAR); xb2.x = xb_xcc_id(); xb2.st = (volatile LAS unsigned*)(lds + LDS_MAIN); xcd_barrier(xb2, wv0); } ++nseam; }
    }
}

extern "C" void kernel_launch(void* const* d_in, const int* in_sizes, int n_in, void* d_out, int out_size, void* d_ws, size_t ws_size, hipStream_t stream) {
    static int grid = 0;
    if (grid == 0) {
        if (n_in != 19 || out_size != MTOK * DM || ws_size < WS_END) { fprintf(stderr, "kernel_launch: unexpected shapes n_in %d out %d ws %zu\n", n_in, out_size, ws_size); grid = -1; return; }
        int dev = 0, cus = 0, per_cu = 0;
        hipGetDevice(&dev);
        hipDeviceGetAttribute(&cus, hipDeviceAttributeMultiprocessorCount, dev);
        if (hipFuncSetAttribute((const void*)mega, hipFuncAttributeMaxDynamicSharedMemorySize, LDS_BYTES) != hipSuccess) { fprintf(stderr, "kernel_launch: hipFuncSetAttribute failed\n"); grid = -1; return; }
        hipOccupancyMaxActiveBlocksPerMultiprocessor(&per_cu, (const void*)mega, NTHREADS, LDS_BYTES);
        if (per_cu < 1) per_cu = 1;
        grid = cus * per_cu;
        (void)hipGetLastError();
    }
    if (grid < 0) return;
    P p{};
    for (int i = 0; i < 19; ++i) p.in[i] = (const float*)d_in[i];
    p.out = (float*)d_out; p.ws = (unsigned char*)d_ws;
#if ONE_LAUNCH
    p.ph_lo = 0; p.ph_hi = NPHASE;
    if (hipMemsetAsync((char*)d_ws + WS_BAR, 0, XCD_BAR_WORDS * 4, stream) != hipSuccess) { fprintf(stderr, "kernel_launch: memset of the barrier words failed\n"); return; }
    void* args[] = {&p};
    hipError_t e = hipLaunchCooperativeKernel((const void*)mega, dim3(grid), dim3(NTHREADS), args, LDS_BYTES, stream);
    if (e != hipSuccess) fprintf(stderr, "cooperative launch failed: %s (grid %d)\n", hipGetErrorString(e), grid);
#else
    for (int ph = 0; ph < NPHASE; ++ph) {
        p.ph_lo = ph; p.ph_hi = ph + 1;
        hipLaunchKernelGGL(mega, dim3(grid), dim3(NTHREADS), LDS_BYTES, stream, p);
    }
#endif
}
```
